# Optimizing an MI355X kernel written in HIP

```python
import functools
import jax
import jax.numpy as jnp
from jax import lax
import numpy as np

D_MODEL = 1024
BATCH = 8
SEQ = 8192
DEPTH = 1
DEC_BATCH = 16
DEC_SEQ = 32
PAST_LEN = 1024

CHUNK = 64
HEAD_DIM = 64
N_HEADS_R = 8
D_R = N_HEADS_R * HEAD_DIM
LORA_W = 64
LORA_A = 64
LORA_G = 128
R_PROJ = 3 * D_R + LORA_W + LORA_A + LORA_G
N_HEADS_A = 8
D_A = N_HEADS_A * HEAD_DIM
BAND_CHUNKS = 8
WINDOW = BAND_CHUNKS * CHUNK
BAND = WINDOW + CHUNK
REL_CLIP = 128
N_REL = 2 * REL_CLIP + 1
D_FF = 4 * D_MODEL
IN_PROJ = R_PROJ + 3 * D_A + 2 * D_MODEL
NORM_EPS = 1e-6
GN_EPS = 64e-5
ATT_SCALE = HEAD_DIM ** -0.5

kernel_name = "hybrid_rwkv7_chunkband_stream_step"


def rms_norm(x, g):
    xf = x.astype(jnp.float32)
    y = xf * lax.rsqrt(jnp.mean(xf * xf, axis=-1, keepdims=True) + NORM_EPS)
    return (y * g.astype(jnp.float32)).astype(x.dtype)


def modulate(x, g, shift, scale):
    return rms_norm(x, g) * (1 + scale) + shift


def wkv7_scan(s0, r, w, k, v, kk, a):
    def step(S, inp):
        r_t, w_t, k_t, v_t, kk_t, a_t = inp
        sa = jnp.einsum("bhvk,bhk->bhv", S, kk_t)
        S = (S * w_t[:, :, None, :]
             - sa[..., None] * (kk_t * a_t)[:, :, None, :]
             + v_t[..., None] * k_t[:, :, None, :])
        return S, jnp.einsum("bhvk,bhk->bhv", S, r_t)
    xs = tuple(jnp.swapaxes(t.astype(jnp.float32), 0, 1) for t in (r, w, k, v, kk, a))
    S, o = lax.scan(step, s0.astype(jnp.float32), xs)
    return S, jnp.swapaxes(o, 0, 1)


def rwkv7_branch(p, prev_row, s0, mu, w_up, w0, a_up, a0, g_up, k_k, k_a, r_k, lnx_g, lnx_b):
    B, T, _ = p.shape
    p_prev = jnp.concatenate([prev_row[:, None, :].astype(p.dtype), p[:, :-1]], axis=1)
    xs = p + (p_prev - p) * mu
    r, k, v, xw, xa, xg = jnp.split(
        xs, [D_R, 2 * D_R, 3 * D_R, 3 * D_R + LORA_W, 3 * D_R + LORA_W + LORA_A], axis=-1)
    w_log = -jax.nn.softplus(-(w0 + jnp.tanh(xw) @ w_up)) - 0.5
    decay = jnp.exp(-jnp.exp(w_log.astype(jnp.float32)))
    a = jax.nn.sigmoid(a0 + xa @ a_up)
    g = jax.nn.sigmoid(xg) @ g_up
    heads = lambda t: t.reshape(B, T, N_HEADS_R, HEAD_DIM)
    kk = heads(k * k_k).astype(jnp.float32)
    kk = kk * lax.rsqrt(jnp.maximum(jnp.sum(kk * kk, axis=-1, keepdims=True), 1e-24))
    k = k * (1 + (a - 1) * k_a)
    rh, kh, vh = heads(r), heads(k), heads(v)
    S, o = wkv7_scan(s0, rh, heads(decay), kh, vh, kk, heads(a))
    mean = jnp.mean(o, axis=-1, keepdims=True)
    var = jnp.mean(jnp.square(o - mean), axis=-1, keepdims=True)
    o = ((o - mean) * lax.rsqrt(var + GN_EPS)).reshape(B, T, D_R)
    o = (o * lnx_g.astype(jnp.float32) + lnx_b.astype(jnp.float32)).astype(p.dtype)
    bonus = (jnp.sum(rh * kh * r_k, axis=-1, keepdims=True) * vh).reshape(B, T, D_R)
    return (o + bonus) * g, S.astype(s0.dtype), p[:, -1]


def rel_bias(table, q_pos, k_pos):
    idx = jnp.clip(q_pos[:, None] - k_pos[None, :], -REL_CLIP, REL_CLIP) + REL_CLIP
    return table[:, idx].astype(jnp.float32)


def band_attend(q, k, v, bias, valid):
    s = jnp.einsum("bqhd,bkhd->bhqk", q, k).astype(jnp.float32) * ATT_SCALE + bias
    s = jnp.where(valid, s, jnp.finfo(jnp.float32).min)
    p = jax.nn.softmax(s, axis=-1).astype(v.dtype)
    return jnp.einsum("bhqk,bkhd->bqhd", p, v)


def chunk_band_attention_prompt(q, k, v, table):
    B, T, H, Dh = q.shape
    n_chunks = T // CHUNK
    kp = jnp.pad(k, ((0, 0), (WINDOW, 0), (0, 0), (0, 0)))
    vp = jnp.pad(v, ((0, 0), (WINDOW, 0), (0, 0), (0, 0)))
    k_off = jnp.arange(BAND) - WINDOW
    bias = rel_bias(table, jnp.arange(CHUNK), k_off)

    def one_chunk(ci):
        start = ci * CHUNK
        qc = lax.dynamic_slice_in_dim(q, start, CHUNK, axis=1)
        kc = lax.dynamic_slice_in_dim(kp, start, BAND, axis=1)
        vc = lax.dynamic_slice_in_dim(vp, start, BAND, axis=1)
        return band_attend(qc, kc, vc, bias, (start + k_off) >= 0)

    out = lax.map(one_chunk, jnp.arange(n_chunks))
    return jnp.moveaxis(out, 0, 1).reshape(B, T, H, Dh)


def chunk_band_attention_step(q, k, v, table, cache_k, cache_v):
    T = q.shape[1]
    L = cache_k.shape[1]
    k_all = jnp.concatenate([cache_k.astype(k.dtype), k], axis=1)
    v_all = jnp.concatenate([cache_v.astype(v.dtype), v], axis=1)
    q_pos = PAST_LEN + jnp.arange(T)
    k_pos = jnp.concatenate([PAST_LEN - L + jnp.arange(L), q_pos])
    return band_attend(q, k_all, v_all, rel_bias(table, q_pos, k_pos), k_pos >= 0)


def trunk_layer(x, c, rwkv_prev, rwkv_s0, attend, P, l):
    B, T, _ = x.shape
    mod = (jax.nn.silu(c) @ P["w_ada"][l] + P["b_ada"][l])[:, None, :]
    sh1, sc1, g1, sh2, sc2, g2 = jnp.split(mod, 6, axis=-1)
    h = modulate(x, P["norm_mix_g"][l], sh1, sc1)
    proj = h @ P["w_in"][l]
    p_r, q, k, v, gates = jnp.split(
        proj, [R_PROJ, R_PROJ + D_A, R_PROJ + 2 * D_A, R_PROJ + 3 * D_A], axis=-1)
    y_r, s_new, last_row = rwkv7_branch(
        p_r, rwkv_prev, rwkv_s0, P["mu_shift"][l], P["w_lora_up"][l], P["w0"][l],
        P["a_lora_up"][l], P["a0"][l], P["g_lora_up"][l], P["k_k"][l], P["k_a"][l],
        P["r_k"][l], P["lnx_g"][l], P["lnx_b"][l])
    q, k, v = (t.reshape(B, T, N_HEADS_A, HEAD_DIM) for t in (q, k, v))
    y_a = attend(q, k, v, P["rel_table"][l]).reshape(B, T, D_A)
    gate_r, gate_a = jnp.split(jax.nn.sigmoid(gates), 2, axis=-1)
    merged = gate_r * (y_r @ P["w_br_r"][l]) + gate_a * (y_a @ P["w_br_a"][l])
    x = x + g1 * (merged @ P["w_out"][l])
    h2 = modulate(x, P["norm_mlp_g"][l], sh2, sc2)
    x = x + g2 * (jnp.square(jax.nn.relu(h2 @ P["w_ff1"][l])) @ P["w_ff2"][l])
    return x, s_new, last_row, k, v


def setup_inputs(seed: int = 0) -> dict:
    key = jax.random.key(seed)
    ks = iter(jax.random.split(key, 40))
    f32 = jnp.float32

    def nrm(shape, scale):
        return jax.random.normal(next(ks), shape, f32) * scale

    n_cache = min(WINDOW, PAST_LEN)
    D = D_MODEL
    return {
        "x_prompt": nrm((BATCH, SEQ, D), 1.0),
        "x_sample": nrm((DEC_BATCH, DEC_SEQ, D), 1.0),
        "c_prompt": nrm((BATCH, D), 1.0),
        "c_sample": nrm((DEC_BATCH, D), 1.0),
        "state_rwkv_wkv": nrm((DEPTH, DEC_BATCH, N_HEADS_R, HEAD_DIM, HEAD_DIM), 0.3),
        "state_rwkv_shift": nrm((DEPTH, DEC_BATCH, R_PROJ), 1.0),
        "cache_att_k": nrm((DEPTH, DEC_BATCH, n_cache, N_HEADS_A, HEAD_DIM), 1.0),
        "cache_att_v": nrm((DEPTH, DEC_BATCH, n_cache, N_HEADS_A, HEAD_DIM), 1.0),
        "w_ada": nrm((DEPTH, D, 6 * D), 0.5 * D ** -0.5),
        "b_ada": nrm((DEPTH, 6 * D), 0.02),
        "norm_mix_g": 1.0 + nrm((DEPTH, D), 0.05),
        "w_in": nrm((DEPTH, D, IN_PROJ), D ** -0.5),
        "mu_shift": jax.random.uniform(next(ks), (DEPTH, R_PROJ), f32),
        "w_lora_up": nrm((DEPTH, LORA_W, D_R), LORA_W ** -0.5),
        "w0": nrm((DEPTH, D_R), 0.5),
        "a_lora_up": nrm((DEPTH, LORA_A, D_R), 0.5 * LORA_A ** -0.5),
        "a0": nrm((DEPTH, D_R), 0.1),
        "g_lora_up": nrm((DEPTH, LORA_G, D_R), LORA_G ** -0.5),
        "k_k": 0.85 + nrm((DEPTH, D_R), 0.05),
        "k_a": 1.0 + nrm((DEPTH, D_R), 0.05),
        "r_k": nrm((DEPTH, N_HEADS_R, HEAD_DIM), 0.1),
        "lnx_g": 1.0 + nrm((DEPTH, D_R), 0.05),
        "lnx_b": nrm((DEPTH, D_R), 0.02),
        "rel_table": nrm((DEPTH, N_HEADS_A, N_REL), 0.1),
        "w_br_r": nrm((DEPTH, D_R, D), D_R ** -0.5),
        "w_br_a": nrm((DEPTH, D_A, D), D_A ** -0.5),
        "w_out": nrm((DEPTH, D, D), D ** -0.5),
        "norm_mlp_g": 1.0 + nrm((DEPTH, D), 0.05),
        "w_ff1": nrm((DEPTH, D, D_FF), D ** -0.5),
        "w_ff2": nrm((DEPTH, D_FF, D), D_FF ** -0.5),
        "final_norm_g": 1.0 + nrm((D,), 0.05),
    }


def reference(x_prompt, x_sample, c_prompt, c_sample, state_rwkv_wkv, state_rwkv_shift,
              cache_att_k, cache_att_v, w_ada, b_ada, norm_mix_g, w_in, mu_shift, w_lora_up, w0,
              a_lora_up, a0, g_lora_up, k_k, k_a, r_k, lnx_g, lnx_b, rel_table, w_br_r, w_br_a,
              w_out, norm_mlp_g, w_ff1, w_ff2, final_norm_g):
    P = dict(w_ada=w_ada, b_ada=b_ada, norm_mix_g=norm_mix_g, w_in=w_in, mu_shift=mu_shift,
             w_lora_up=w_lora_up, w0=w0, a_lora_up=a_lora_up, a0=a0, g_lora_up=g_lora_up,
             k_k=k_k, k_a=k_a, r_k=r_k, lnx_g=lnx_g, lnx_b=lnx_b, rel_table=rel_table,
             w_br_r=w_br_r, w_br_a=w_br_a, w_out=w_out, norm_mlp_g=norm_mlp_g,
             w_ff1=w_ff1, w_ff2=w_ff2)
    Bp, Tp, _ = x_prompt.shape
    n_keep = min(WINDOW, Tp)
    xp, xs = x_prompt, x_sample
    p_wkv, p_shift, p_k, p_v = [], [], [], []
    s_wkv, s_shift, s_k, s_v = [], [], [], []
    for l in range(DEPTH):
        zero_row = jnp.zeros((Bp, R_PROJ), x_prompt.dtype)
        zero_state = jnp.zeros((Bp, N_HEADS_R, HEAD_DIM, HEAD_DIM), x_prompt.dtype)
        xp, sp, rp, kp, vp = trunk_layer(xp, c_prompt, zero_row, zero_state,
                                         chunk_band_attention_prompt, P, l)
        p_wkv.append(sp)
        p_shift.append(rp)
        p_k.append(kp[:, Tp - n_keep:])
        p_v.append(vp[:, Tp - n_keep:])
        attend = functools.partial(chunk_band_attention_step,
                                   cache_k=cache_att_k[l], cache_v=cache_att_v[l])
        xs, ss, rs, ks_, vs_ = trunk_layer(xs, c_sample, state_rwkv_shift[l], state_rwkv_wkv[l],
                                           attend, P, l)
        s_wkv.append(ss)
        s_shift.append(rs)
        s_k.append(ks_)
        s_v.append(vs_)
    y_prompt = rms_norm(xp, final_norm_g)
    y_sample = rms_norm(xs, final_norm_g)
    return (y_prompt, y_sample,
            jnp.stack(p_wkv), jnp.stack(p_shift), jnp.stack(p_k), jnp.stack(p_v),
            jnp.stack(s_wkv), jnp.stack(s_shift), jnp.stack(s_k), jnp.stack(s_v))
```

```cpp
#include <hip/hip_runtime.h>
#include <hip/hip_cooperative_groups.h>
#include <cstdio>
#include <cstdint>
namespace cg = cooperative_groups;
namespace pg8 {
#define PG8_LAS __attribute__((address_space(3)))
typedef unsigned short bf16_t;
typedef short bf16x8 __attribute__((ext_vector_type(8)));
typedef float f32x4 __attribute__((ext_vector_type(4)));
typedef unsigned u32x4 __attribute__((ext_vector_type(4)));
constexpr int BM = 256, BK = 64, HALF = 128, HTB = HALF * BK * 2  , STAGE_BYTES = 8 * HTB, NXCD = 8, WGM = 8;

__host__ __device__ __forceinline__ int lds_byte(int r, int c) { const int st = (r >> 4) * 2 + (c >> 5), rr = r & 15, cc = c & 31, ob = rr * 64 + cc * 2; return st * 1024 + (ob ^ (((ob >> 9) & 1) << 5)); }
__host__ __device__ __forceinline__ void stage_rc(int b, int& R, int& C) { const int st = b / 1024, sb = b % 1024, swz = sb ^ (((sb >> 9) & 1) << 5); R = (st >> 1) * 16 + swz / 64; C = (st & 1) * 32 + (swz % 64) / 2; }
__host__ __device__ __forceinline__ int perm32(int rho) { const int n = rho >> 4, i = rho & 15; return 8 * (i >> 2) + 4 * n + (i & 3); }

struct Unit { int pm, pn, kofs; };
struct Gemm { const bf16_t* A; const bf16_t* Bt; int M, N, K, ld; };

struct StaticOrder {
    int nM, nN, nwg, G, c;
    __host__ __device__ void init(int M, int N, int G_, int c_) { nM = M / BM; nN = N / BM; nwg = nM * nN; G = G_; c = c_; }
    __host__ __device__ bool next(int i, Unit& u) const {
        const long L = (long)i * G + c; if (L >= nwg) return false;
        int wgid = (int)L; { const int q = nwg / NXCD, r = nwg % NXCD, xcd = wgid % NXCD, off = wgid / NXCD; wgid = (xcd < r ? xcd * (q + 1) : r * (q + 1) + (xcd - r) * q) + off; }
        const int nig = WGM * nN, gid = wgid / nig, fm = gid * WGM, gsz = (nM - fm) < WGM ? (nM - fm) : WGM;
        u.pm = fm + ((wgid % nig) % gsz); u.pn = (wgid % nig) / gsz; u.kofs = 0; return true;
    }
    __device__ __forceinline__ void a_ready(const Unit&) const {}
    __device__ __forceinline__ void done(const Unit&) const {}
};

__device__ __forceinline__ unsigned cvt_pk_bf16(float lo, float hi) { unsigned r; asm volatile("v_cvt_pk_bf16_f32 %0, %1, %2" : "=v"(r) : "v"(lo), "v"(hi)); return r; }
template <class Epi, class Sched, bool ALIGN_EPI = false, bool SP2 = false>
__device__ __forceinline__ void gemm_phase(PG8_LAS unsigned char* lds, const Gemm g, const Sched& S, const Epi& E, const int wid_in) {
    int tid_; asm volatile("v_mbcnt_lo_u32_b32 %0, -1, 0\n\tv_mbcnt_hi_u32_b32 %0, -1, %0" : "=v"(tid_)); tid_ += wid_in * 64;
    const int tid = tid_, wid = __builtin_amdgcn_readfirstlane(tid >> 6), lane = tid & 63, wr = wid >> 2, wc = wid & 3, fr = lane & 15, fq = lane >> 4;
    const int K = g.K, nt = K / BK;
    unsigned voffA[2], voffB[2];
#pragma unroll
    for (int i = 0; i < 2; ++i) { int R, C; stage_rc(tid * 16 + i * 8192, R, C); const int Rb = Epi::PERM ? ((R & ~31) + perm32(R & 31)) : R;
        voffA[i] = (unsigned)(R * g.ld + C) * 2u; voffB[i] = (unsigned)(Rb * g.ld + C) * 2u; }
    const size_t kstep = (size_t)(BK * 2);
    const size_t hstep = (size_t)HALF * g.ld * 2;
    const size_t tstep = 2 * hstep;
    const unsigned ldsw = (unsigned)wid * 1024u;
    const int aoff = lds_byte(wr * 64 + fr, fq * 8), boff = lds_byte(wc * 32 + fr, fq * 8);
#define PG8_SA(b, h) (((b) * 2 + (h)) * HTB)
#define PG8_SB(b, h) ((4 + (b) * 2 + (h)) * HTB)
#define PG8_STAGE(bufoff, gbase, voff) do { _Pragma("unroll") for (int _i = 0; _i < 2; ++_i) \
        __builtin_amdgcn_global_load_lds((const unsigned*)((const char*)(gbase) + (voff)[_i]), (PG8_LAS unsigned*)(lds + (bufoff) + ldsw + _i * 8192), 16, 0, 0); } while (0)
#define PG8_LDA(dst, b, h) do { _Pragma("unroll") for (int m = 0; m < 4; ++m) _Pragma("unroll") for (int k = 0; k < 2; ++k) dst[m][k] = *(const PG8_LAS bf16x8*)(lds + PG8_SA(b, h) + aoff + m * 2048 + k * 1024); } while (0)
#define PG8_LDB(dst, b, h) do { _Pragma("unroll") for (int n = 0; n < 2; ++n) _Pragma("unroll") for (int k = 0; k < 2; ++k) dst[n][k] = *(const PG8_LAS bf16x8*)(lds + PG8_SB(b, h) + boff + n * 2048 + k * 1024); } while (0)
#define PG8_MMA(ai, bj, At, Bt) do { __builtin_amdgcn_s_setprio(1); _Pragma("unroll") for (int m = 0; m < 4; ++m) _Pragma("unroll") for (int n = 0; n < 2; ++n) _Pragma("unroll") for (int k = 0; k < 2; ++k) \
        acc[ai][bj][m][n] = __builtin_amdgcn_mfma_f32_16x16x32_bf16(Bt[n][k], At[m][k], acc[ai][bj][m][n], 0, 0, 0); __builtin_amdgcn_s_setprio(0); } while (0)
#define PG8_WAIT_V(n) asm volatile("s_waitcnt vmcnt(" #n ")" ::: "memory")
#define PG8_WAIT_L(n) asm volatile("s_waitcnt lgkmcnt(" #n ")" ::: "memory")
#define PG8_BAR __builtin_amdgcn_s_barrier()
#define PG8_SCHED __builtin_amdgcn_sched_barrier(0)
    Unit cur, nxt; int ui = 0;
    if (!S.next(0, cur)) return;
    f32x4 acc[2][2][4][2];
#pragma unroll
    for (int a = 0; a < 2; ++a)
#pragma unroll
        for (int b = 0; b < 2; ++b)
#pragma unroll
            for (int m = 0; m < 4; ++m)
#pragma unroll
                for (int n = 0; n < 2; ++n) acc[a][b][m][n] = (f32x4){0.f, 0.f, 0.f, 0.f};
    bf16x8 At[4][2], B0[2][2], B1[2][2];
    const char* cA = (const char*)g.A + (size_t)cur.pm * tstep + (size_t)cur.kofs * 2; const char* cB = (const char*)g.Bt + (size_t)cur.pn * tstep + (size_t)cur.kofs * 2;
    S.a_ready(cur);
    if constexpr (SP2) {
        PG8_STAGE(PG8_SB(0, 0), cB, voffB); PG8_STAGE(PG8_SB(0, 1), cB + hstep, voffB); PG8_STAGE(PG8_SA(0, 0), cA, voffA); PG8_STAGE(PG8_SA(0, 1), cA + hstep, voffA);
        if (wr == 1) PG8_BAR;
        PG8_WAIT_V(2); PG8_BAR;
        PG8_STAGE(PG8_SB(1, 0), cB + kstep, voffB); PG8_STAGE(PG8_SA(1, 0), cA + kstep, voffA); PG8_STAGE(PG8_SB(1, 1), cB + hstep + kstep, voffB);
        PG8_WAIT_V(6); PG8_BAR;
    } else {
        PG8_STAGE(PG8_SB(0, 0), cB, voffB); PG8_STAGE(PG8_SA(0, 0), cA, voffA); PG8_STAGE(PG8_SB(0, 1), cB + hstep, voffB); PG8_STAGE(PG8_SA(0, 1), cA + hstep, voffA);
        if (wr == 1) PG8_BAR;
        PG8_WAIT_V(4); PG8_BAR;
        PG8_STAGE(PG8_SB(1, 0), cB + kstep, voffB); PG8_STAGE(PG8_SA(1, 0), cA + kstep, voffA); PG8_STAGE(PG8_SB(1, 1), cB + hstep + kstep, voffB);
        PG8_WAIT_V(6); PG8_BAR;
    }
    for (;;) {
        const bool has_next = S.next(ui + 1, nxt);
        const char* nA = has_next ? (const char*)g.A + (size_t)nxt.pm * tstep + (size_t)nxt.kofs * 2 : cA; const char* nB = has_next ? (const char*)g.Bt + (size_t)nxt.pn * tstep + (size_t)nxt.kofs * 2 : cB;
        for (int t = 0; t < nt; t += 2) {
            const bool last = (t == nt - 2);
            const char* a1 = cA + (size_t)(t + 1) * kstep;
            const char* a2 = last ? nA : cA + (size_t)(t + 2) * kstep; const char* b2 = last ? nB : cB + (size_t)(t + 2) * kstep;
            const char* a3 = a2 + kstep; const char* b3 = b2 + kstep;
            if (last && has_next) S.a_ready(nxt);
            if constexpr (Epi::MID) { if (2 * t == nt) E.mid(acc, cur, wr, wc, fr, fq); }
            if constexpr (SP2) {
            PG8_LDB(B0, 0, 0); PG8_LDB(B1, 0, 1); PG8_SCHED; PG8_LDA(At, 0, 0); PG8_STAGE(PG8_SA(1, 1), a1 + hstep, voffA);
            PG8_WAIT_V(8); PG8_WAIT_L(0); PG8_BAR; PG8_MMA(0, 0, At, B0); PG8_MMA(0, 1, At, B1); PG8_BAR; PG8_SCHED;
            PG8_LDA(At, 0, 1); PG8_STAGE(PG8_SB(0, 0), b2, voffB); PG8_STAGE(PG8_SB(0, 1), b2 + hstep, voffB); PG8_STAGE(PG8_SA(0, 0), a2, voffA);
            PG8_WAIT_V(8); PG8_WAIT_L(0); PG8_BAR; PG8_MMA(1, 0, At, B0); PG8_MMA(1, 1, At, B1); PG8_BAR; PG8_SCHED;
            PG8_LDB(B0, 1, 0); PG8_LDB(B1, 1, 1); PG8_SCHED; PG8_LDA(At, 1, 0); PG8_STAGE(PG8_SA(0, 1), a2 + hstep, voffA);
            PG8_WAIT_V(8); PG8_WAIT_L(0); PG8_BAR; PG8_MMA(0, 0, At, B0); PG8_MMA(0, 1, At, B1); PG8_BAR; PG8_SCHED;
            PG8_LDA(At, 1, 1); PG8_STAGE(PG8_SB(1, 0), b3, voffB); PG8_STAGE(PG8_SB(1, 1), b3 + hstep, voffB); PG8_STAGE(PG8_SA(1, 0), a3, voffA);
            PG8_WAIT_V(8); PG8_WAIT_L(0); PG8_BAR; PG8_MMA(1, 0, At, B0); PG8_MMA(1, 1, At, B1); PG8_BAR; PG8_SCHED;
            } else {
            PG8_LDB(B0, 0, 0); PG8_SCHED; PG8_LDA(At, 0, 0); PG8_STAGE(PG8_SA(1, 1), a1 + hstep, voffA);
            PG8_WAIT_L(8); PG8_BAR; PG8_WAIT_L(0); PG8_MMA(0, 0, At, B0); PG8_BAR; PG8_SCHED;
            PG8_LDB(B1, 0, 1); PG8_STAGE(PG8_SB(0, 0), b2, voffB);
            PG8_BAR; PG8_WAIT_L(0); PG8_MMA(0, 1, At, B1); PG8_BAR;
            PG8_LDA(At, 0, 1); PG8_STAGE(PG8_SA(0, 0), a2, voffA);
            PG8_BAR; PG8_WAIT_L(0); PG8_MMA(1, 0, At, B0); PG8_BAR; PG8_SCHED;
            PG8_STAGE(PG8_SB(0, 1), b2 + hstep, voffB);
            PG8_WAIT_V(6); PG8_BAR; PG8_MMA(1, 1, At, B1); PG8_BAR;
            PG8_LDB(B0, 1, 0); PG8_SCHED; PG8_LDA(At, 1, 0); PG8_STAGE(PG8_SA(0, 1), a2 + hstep, voffA);
            PG8_WAIT_L(8); PG8_BAR; PG8_WAIT_L(0); PG8_MMA(0, 0, At, B0); PG8_BAR; PG8_SCHED;
            PG8_LDB(B1, 1, 1); PG8_STAGE(PG8_SB(1, 0), b3, voffB);
            PG8_BAR; PG8_WAIT_L(0); PG8_MMA(0, 1, At, B1); PG8_BAR;
            PG8_LDA(At, 1, 1); PG8_STAGE(PG8_SA(1, 0), a3, voffA);
            PG8_BAR; PG8_WAIT_L(0); PG8_MMA(1, 0, At, B0); PG8_BAR; PG8_SCHED;
            PG8_STAGE(PG8_SB(1, 1), b3 + hstep, voffB);
            PG8_WAIT_V(6); PG8_BAR; PG8_MMA(1, 1, At, B1); PG8_BAR;
            }
        }
        if constexpr (ALIGN_EPI) { if (wr == 0) PG8_BAR; }
        if constexpr (!Epi::AFTER_DRAIN) { E(acc, cur, wr, wc, fr, fq); S.done(cur); }
        if (!has_next) break;
#pragma unroll
        for (int a = 0; a < 2; ++a)
#pragma unroll
            for (int b = 0; b < 2; ++b)
#pragma unroll
                for (int m = 0; m < 4; ++m)
#pragma unroll
                    for (int n = 0; n < 2; ++n) acc[a][b][m][n] = (f32x4){0.f, 0.f, 0.f, 0.f};
        cur = nxt; cA = nA; cB = nB; ++ui;
        if constexpr (ALIGN_EPI) { if (wr == 1) PG8_BAR; }
    }
    PG8_WAIT_V(0);
    if constexpr (!ALIGN_EPI) { if (wr == 0) PG8_BAR; }
    PG8_BAR;
    if constexpr (Epi::AFTER_DRAIN) { E.fused(acc, cur, wr, wc, fr, fq, lds, wid, lane); S.done(cur); }
#undef PG8_SA
#undef PG8_SB
#undef PG8_STAGE
#undef PG8_LDA
#undef PG8_LDB
#undef PG8_MMA
#undef PG8_WAIT_V
#undef PG8_WAIT_L
#undef PG8_BAR
#undef PG8_SCHED
}
}

#define DI __device__ __forceinline__
#define LAS __attribute__((address_space(3)))
typedef unsigned short bf16_t;
typedef short bf16x8 __attribute__((ext_vector_type(8)));
typedef float f32x4 __attribute__((ext_vector_type(4)));
typedef float f32x2 __attribute__((ext_vector_type(2)));
typedef float f32x16 __attribute__((ext_vector_type(16)));
typedef unsigned u32x4 __attribute__((ext_vector_type(4)));
typedef unsigned u32x2 __attribute__((ext_vector_type(2)));
typedef __bf16 bf16x2_t __attribute__((ext_vector_type(2)));
#define MFMA32(a, b, c) __builtin_amdgcn_mfma_f32_32x32x16_bf16((a), (b), (c), 0, 0, 0)

constexpr int D = 1024, TP = 8192, MP = 65536, MS = 512, M = MP + MS, NSEQ = 24;
constexpr int RPROJ = 1792, INPROJ = 5376, DFF = 4096;
constexpr int NTHREADS = 512, NWAVES = 8;
constexpr int LDS_BYTES = 147456;
constexpr float L2E = 1.4426950408889634f;

constexpr size_t OUT_PWKV = 67633152, OUT_PSHIFT = 67895296, OUT_PK = 67909632, OUT_PV = 70006784,
                 OUT_SWKV = 72103936, OUT_SSHIFT = 72628224, OUT_SK = 72656896, OUT_SV = 72919040;

constexpr size_t al256(size_t x) { return (x + 255) & ~(size_t)255; }
constexpr size_t WS_WIN = 0;
constexpr size_t WS_WBRR = WS_WIN + (size_t)INPROJ * D * 2;
constexpr size_t WS_WBRA = WS_WBRR + (size_t)D * 512 * 2;
constexpr size_t WS_WOUT = WS_WBRA + (size_t)D * 512 * 2;
constexpr size_t WS_W1 = WS_WOUT + (size_t)D * D * 2;
constexpr size_t WS_W2 = WS_W1 + (size_t)DFF * D * 2;
constexpr size_t WS_WUP = WS_W2 + (size_t)DFF * D * 2;
constexpr size_t WS_AUP = WS_WUP + 512 * 64 * 2;
constexpr size_t WS_GUP = WS_AUP + 512 * 64 * 2;
constexpr size_t WS_MOD = WS_GUP + 512 * 128 * 2;
constexpr size_t WS_RK = al256(WS_MOD + (size_t)NSEQ * 6144 * 4);
constexpr size_t WS_KS = al256(WS_RK + (size_t)M * 8 * 4);
constexpr size_t WS_VTS = WS_KS + (size_t)16 * 576 * 512 * 2;
constexpr size_t WS_ACTA = WS_VTS + (size_t)16 * 576 * 512 * 2;
constexpr size_t WS_PR = WS_ACTA + (size_t)M * D * 2;
constexpr size_t WS_QB = WS_PR + (size_t)M * RPROJ * 2;
constexpr size_t WS_KB = WS_QB + (size_t)M * 512 * 2;
constexpr size_t WS_VT = WS_KB + (size_t)M * 512 * 2;
constexpr size_t WS_GATES = WS_VT + (size_t)M * 512 * 2;
constexpr size_t WS_YR = WS_GATES + (size_t)M * 2048 * 2;
constexpr size_t WS_YA = WS_YR + (size_t)M * 512 * 2;
constexpr size_t WS_BAR = WS_YA + (size_t)M * 512 * 2;
constexpr size_t WS_BAR_BYTES = 16384;
constexpr size_t WS_PART1 = WS_BAR + WS_BAR_BYTES;
constexpr size_t WS_PART2 = WS_PART1 + (size_t)4 * MS * D * 4;
constexpr size_t WS_END = WS_PART2 + (size_t)8 * MS * D * 4;
static_assert(WS_END <= ((size_t)1 << 30), "workspace map must fit 1 GiB");
static_assert((size_t)M * DFF * 2 <= WS_YR - WS_PR, "f overlay");
constexpr size_t WS_PBUF = WS_ACTA;
constexpr size_t WS_UBUF = WS_PBUF + (size_t)64 * 32 * 4096 * 4;
constexpr size_t WS_SST = WS_UBUF + (size_t)64 * 32 * 4096 * 4;
static_assert(WS_SST + (size_t)64 * 33 * 4096 * 4 <= WS_PR, "PU overlay");

struct Params { const float* in[31]; float* out; unsigned char* ws; };

DI float bf2f(bf16_t v) { return __builtin_bit_cast(float, (unsigned)v << 16); }
DI unsigned pk2(float lo, float hi) { f32x2 v = {lo, hi}; bf16x2_t b = __builtin_convertvector(v, bf16x2_t); return __builtin_bit_cast(unsigned, b); }
DI bf16_t f2bf(float f) { return (bf16_t)(pk2(f, 0.f) & 0xffffu); }
DI float lo_bf(unsigned u) { return __builtin_bit_cast(float, u << 16); }
DI float hi_bf(unsigned u) { return __builtin_bit_cast(float, u & 0xffff0000u); }
DI float sigmoidf_(float x) { return __builtin_amdgcn_rcpf(1.0f + __builtin_amdgcn_exp2f(-x * L2E)); }
#define DPP_ADD(v, ctrl) ((v) + __builtin_bit_cast(float, __builtin_amdgcn_update_dpp(0, __builtin_bit_cast(int, (v)), (ctrl), 0xf, 0xf, true)))
DI float wave_sum(float v) {
    v = DPP_ADD(v, 0xB1);
    v = DPP_ADD(v, 0x4E);
    v = DPP_ADD(v, 0x141);
    v = DPP_ADD(v, 0x140);
    const int iv = __builtin_bit_cast(int, v);
    const float a = __builtin_bit_cast(float, __builtin_amdgcn_readlane(iv, 0)), b = __builtin_bit_cast(float, __builtin_amdgcn_readlane(iv, 16));
    const float c = __builtin_bit_cast(float, __builtin_amdgcn_readlane(iv, 32)), d = __builtin_bit_cast(float, __builtin_amdgcn_readlane(iv, 48));
    return (a + b) + (c + d);
}
DI int opaque(int v) { asm volatile("" : "+v"(v)); return v; }
DI int lane_now() { int l; asm volatile("v_mbcnt_lo_u32_b32 %0, -1, 0\n\tv_mbcnt_hi_u32_b32 %0, -1, %0" : "=v"(l)); return l; }
DI int seq_of_row(int row) { return row < MP ? (row >> 13) : 8 + ((row - MP) >> 5); }
DI const float* xrow_ptr(const Params& p, int row) { return row < MP ? p.in[0] + (size_t)row * D : p.in[1] + (size_t)(row - MP) * D; }

#define XB_TMO      128
#define XB_XCNT(j)  (256  + 64 * (j))
#define XB_XSUB(j)  (1280 + 64 * (j))
#define XB_XGEN(j)  (2304 + 64 * (j))
#define XB_TOP      3328
#define XB_TOPGEN   3392
#define XCD_BAR_WORDS 3456
#define XB_SPIN_CAP (1u << 22)

__device__ __forceinline__ unsigned xb_ld(unsigned* p)              { return __hip_atomic_load(p, __ATOMIC_RELAXED, __HIP_MEMORY_SCOPE_AGENT); }
__device__ __forceinline__ unsigned xb_add(unsigned* p, unsigned v) { return __hip_atomic_fetch_add(p, v, __ATOMIC_RELAXED, __HIP_MEMORY_SCOPE_AGENT); }
__device__ __forceinline__ unsigned xb_xcc_id() { return (unsigned)__builtin_amdgcn_s_getreg((3 << 11) | 20) & 0xFu; }
#define XB_SPIN(cond, bar) do { unsigned _sp = 0; while (cond) { __builtin_amdgcn_s_sleep(1); \
    if ((++_sp & 255u) == 0u) { if (xb_ld(&(bar)[XB_TMO])) break; if (_sp > XB_SPIN_CAP) { atomicAdd(&(bar)[XB_TMO], 1u); break; } } } } while (0)

struct XcdBarrier {
    int w0;
    unsigned* bar; unsigned x;
    volatile LAS unsigned* st;
};

__device__ __forceinline__ XcdBarrier xcd_barrier_post(unsigned* bar, volatile LAS unsigned* st) {
    XcdBarrier b; b.bar = bar; b.x = xb_xcc_id(); b.st = st;
    if (threadIdx.x == 0) (void)xb_add(&bar[XB_XCNT(b.x)], 1u);
    return b;
}
__device__ __forceinline__ void xcd_barrier_complete(unsigned* bar, unsigned x, unsigned& nloc, unsigned& nx) {
    const unsigned G = gridDim.x * gridDim.y * gridDim.z;
    unsigned sum, cnt, mine, sp = 0u;
    for (;;) {
        sum = 0u; cnt = 0u; mine = 0u;
#pragma unroll
        for (unsigned j = 0; j < 16; ++j) { const unsigned c = xb_ld(&bar[XB_XCNT(j)]); sum += c; cnt += (c > 0u) ? 1u : 0u; mine = (j == x) ? c : mine; }
        if (sum == G) break;
        __builtin_amdgcn_s_sleep(1);
        if ((++sp & 255u) == 0u) { if (xb_ld(&bar[XB_TMO])) break; if (sp > XB_SPIN_CAP) { atomicAdd(&bar[XB_TMO], 1u); break; } }
    }
    nloc = mine > 0u ? mine : 1u; nx = cnt > 0u ? cnt : 1u;
}

__device__ __forceinline__ void xcd_barrier(const XcdBarrier& b) {
    asm volatile("s_waitcnt vmcnt(0)" ::: "memory");
    __syncthreads();
    if (b.w0 == 0 && lane_now() == 0) {
        unsigned* bar = b.bar;
        __builtin_amdgcn_s_waitcnt(0);
        unsigned nloc = b.st[0], nx = b.st[1];
        if (nloc == 0u) { xcd_barrier_complete(bar, b.x, nloc, nx); b.st[0] = nloc; b.st[1] = nx; }
        const unsigned old = xb_add(&bar[XB_XSUB(b.x)], 1u);
        const unsigned gen = old / nloc;
        if (old + 1u == (gen + 1u) * nloc) {
            __builtin_amdgcn_fence(__ATOMIC_RELEASE, "agent");
            asm volatile("s_waitcnt vmcnt(0)" ::: "memory");
            const unsigned og = xb_add(&bar[XB_TOP], 1u);
            const unsigned tg = og / nx;
            if (og + 1u == (tg + 1u) * nx) xb_add(&bar[XB_TOPGEN], 1u);
            else XB_SPIN(xb_ld(&bar[XB_TOPGEN]) == tg, bar);
            __builtin_amdgcn_fence(__ATOMIC_ACQUIRE, "agent");
            xb_add(&bar[XB_XGEN(b.x)], 1u);
            asm volatile("s_waitcnt vmcnt(0)" ::: "memory");
        } else {
            XB_SPIN(xb_ld(&bar[XB_XGEN(b.x)]) == gen, bar);
            __builtin_amdgcn_fence(__ATOMIC_ACQUIRE, "agent");
            asm volatile("s_waitcnt vmcnt(0)" ::: "memory");
        }
    }
    __syncthreads();
}


#define EPI_LOOP_BEGIN \
    _Pragma("unroll") for (int ai = 0; ai < 2; ++ai) _Pragma("unroll") for (int m = 0; m < 4; ++m) { \
        const int row = u.pm * 256 + ai * 128 + wr * 64 + m * 16 + fr; \
        _Pragma("unroll") for (int bj = 0; bj < 2; ++bj) { \
            const int col0 = u.pn * 256 + bj * 128 + wc * 32 + 8 * fq; \
            const f32x4 v0 = acc[ai][bj][m][0], v1 = acc[ai][bj][m][1];
#define EPI_LOOP_END } }

DI u32x4 pack8(f32x4 a, f32x4 b) { u32x4 w; w.x = pk2(a[0], a[1]); w.y = pk2(a[2], a[3]); w.z = pk2(b[0], b[1]); w.w = pk2(b[2], b[3]); return w; }

struct EpiProj {
    static constexpr bool PERM = true, AFTER_DRAIN = false, MID = false;
    bf16_t *pr, *qb, *kb, *vt, *gates, *ks, *vts; float* out;
    DI void operator()(const f32x4 (&acc)[2][2][4][2], const pg8::Unit& u, int wr, int wc, int fr, int fq) const {
        const int pn = u.pn;
        if (pn < 7) {
            EPI_LOOP_BEGIN
                *(u32x4*)(pr + (size_t)row * RPROJ + col0) = pack8(v0, v1);
                float* so = nullptr;
                if (row < MP) { if ((row & 8191) == 8191) so = out + OUT_PSHIFT + (size_t)(row >> 13) * RPROJ + col0; }
                else { if (((row - MP) & 31) == 31) so = out + OUT_SSHIFT + (size_t)((row - MP) >> 5) * RPROJ + col0; }
                if (so) { *(f32x4*)so = v0; *(f32x4*)(so + 4) = v1; }
            EPI_LOOP_END
        } else if (pn < 9) {
            EPI_LOOP_BEGIN
                const int c = col0 - 1792, hh = c >> 6, d = c & 63;
                size_t qi;
                if (row < MP) qi = ((size_t)((row >> 13) * 8 + hh) * 8192 + (row & 8191)) * 64 + d;
                else { const int sr = row - MP; qi = (size_t)MP * 512 + ((size_t)((sr >> 5) * 8 + hh) * 32 + (sr & 31)) * 64 + d; }
                *(u32x4*)(qb + qi) = pack8(v0 * (0.125f * L2E), v1 * (0.125f * L2E));
            EPI_LOOP_END
        } else if (pn < 11) {
            EPI_LOOP_BEGIN
                const int c = col0 - 2304, hh = c >> 6, d = c & 63;
                const u32x4 w = pack8(v0, v1);
                float* so = nullptr;
                if (row < MP) { const int t = row & 8191, b = row >> 13; if (t >= 7680) so = out + OUT_PK + ((size_t)b * 512 + (t - 7680)) * 512 + c;
                                *(u32x4*)(kb + ((size_t)(b * 8 + hh) * 8192 + t) * 64 + d) = w; }
                else { const int sr = row - MP; so = out + OUT_SK + (size_t)sr * 512 + c;
                       *(u32x4*)(ks + ((size_t)((sr >> 5) * 8 + hh) * 576 + 512 + (sr & 31)) * 64 + d) = w; }
                if (so) { *(f32x4*)so = v0; *(f32x4*)(so + 4) = v1; }
            EPI_LOOP_END
        } else if (pn < 13) {
            EPI_LOOP_BEGIN
                const int c = col0 - 2816, hh = c >> 6, d = c & 63;
                float* so = nullptr; bf16_t* tp; const size_t pitch = 32;
                if (row < MP) { const int t = row & 8191, b = row >> 13; if (t >= 7680) so = out + OUT_PV + ((size_t)b * 512 + (t - 7680)) * 512 + c;
                                tp = vt + (((size_t)(b * 8 + hh) * 256 + (t >> 5)) * 64 + d) * 32 + (t & 31); }
                else { const int sr = row - MP; so = out + OUT_SV + (size_t)sr * 512 + c;
                       tp = vts + (((size_t)((sr >> 5) * 8 + hh) * 18 + 16) * 64 + d) * 32 + (sr & 31); }
                if (so) { *(f32x4*)so = v0; *(f32x4*)(so + 4) = v1; }
                tp[0] = f2bf(v0[0]); tp[pitch] = f2bf(v0[1]); tp[2 * pitch] = f2bf(v0[2]); tp[3 * pitch] = f2bf(v0[3]);
                tp[4 * pitch] = f2bf(v1[0]); tp[5 * pitch] = f2bf(v1[1]); tp[6 * pitch] = f2bf(v1[2]); tp[7 * pitch] = f2bf(v1[3]);
            EPI_LOOP_END
        } else {
            EPI_LOOP_BEGIN
                f32x4 s0, s1;
#pragma unroll
                for (int i = 0; i < 4; ++i) { s0[i] = sigmoidf_(v0[i]); s1[i] = sigmoidf_(v1[i]); }
                *(u32x4*)(gates + (size_t)row * 2048 + (col0 - 3328)) = pack8(s0, s1);
            EPI_LOOP_END
        }
    }
};

DI void unpack8(u32x4 w, f32x4& a, f32x4& b) { a[0] = lo_bf(w.x); a[1] = hi_bf(w.x); a[2] = lo_bf(w.y); a[3] = hi_bf(w.y); b[0] = lo_bf(w.z); b[1] = hi_bf(w.z); b[2] = lo_bf(w.w); b[3] = hi_bf(w.w); }

struct EpiMerge {
    static constexpr bool PERM = true, AFTER_DRAIN = false, MID = true;
    const bf16_t* gates; bf16_t* O;
    DI void mid(f32x4 (&acc)[2][2][4][2], const pg8::Unit& u, int wr, int wc, int fr, int fq) const {
#pragma unroll
        for (int ai = 0; ai < 2; ++ai)
#pragma unroll
            for (int m = 0; m < 4; ++m) {
                const int row = u.pm * 256 + ai * 128 + wr * 64 + m * 16 + fr;
#pragma unroll
                for (int bj = 0; bj < 2; ++bj) {
                    const int col0 = u.pn * 256 + bj * 128 + wc * 32 + 8 * fq;
                    f32x4 r0, r1, a0, a1;
                    unpack8(*(const u32x4*)(gates + (size_t)row * 2048 + col0), r0, r1);
                    unpack8(*(const u32x4*)(gates + (size_t)row * 2048 + 1024 + col0), a0, a1);
#pragma unroll
                    for (int i = 0; i < 4; ++i) { acc[ai][bj][m][0][i] *= r0[i] * __builtin_amdgcn_rcpf(fmaxf(a0[i], 1e-30f)); acc[ai][bj][m][1][i] *= r1[i] * __builtin_amdgcn_rcpf(fmaxf(a1[i], 1e-30f)); }
                }
            }
    }
    DI void operator()(const f32x4 (&acc)[2][2][4][2], const pg8::Unit& u, int wr, int wc, int fr, int fq) const {
        EPI_LOOP_BEGIN
            f32x4 a0, a1; unpack8(*(const u32x4*)(gates + (size_t)row * 2048 + 1024 + col0), a0, a1);
            *(u32x4*)(O + (size_t)row * D + col0) = pack8(v0 * a0, v1 * a1);
        EPI_LOOP_END
    }
};
struct EpiRes {
    static constexpr bool PERM = true, AFTER_DRAIN = false, MID = false;
    const float* xp; const float* xs; const float* mod; int moff; float* dst;
    DI void operator()(const f32x4 (&acc)[2][2][4][2], const pg8::Unit& u, int wr, int wc, int fr, int fq) const {
        EPI_LOOP_BEGIN
            const float* src = (row < MP ? xp + (size_t)row * D : xs + (size_t)(row - MP) * D) + col0;
            const float* mg = mod + (size_t)seq_of_row(row) * 6144 + moff + col0;
            const f32x4 x0 = *(const f32x4*)src, x1 = *(const f32x4*)(src + 4), m0 = *(const f32x4*)mg, m1 = *(const f32x4*)(mg + 4);
            float* dp = dst + (size_t)row * D + col0;
            *(f32x4*)dp = x0 + m0 * v0; *(f32x4*)(dp + 4) = x1 + m1 * v1;
        EPI_LOOP_END
    }
};
struct EpiResB16 {
    static constexpr bool PERM = true, AFTER_DRAIN = false, MID = false;
    const float* xp; const float* mod; int moff; bf16_t* xb; bool inplace;
    DI void operator()(const f32x4 (&acc)[2][2][4][2], const pg8::Unit& u, int wr, int wc, int fr, int fq) const {
        EPI_LOOP_BEGIN
            const float* mg = mod + (size_t)(row >> 13) * 6144 + moff + col0;
            const f32x4 m0 = *(const f32x4*)mg, m1 = *(const f32x4*)(mg + 4);
            bf16_t* dp = xb + (size_t)row * D + col0;
            f32x4 x0, x1;
            if (inplace) unpack8(*(const u32x4*)dp, x0, x1);
            else { const float* src = xp + (size_t)row * D + col0; x0 = *(const f32x4*)src; x1 = *(const f32x4*)(src + 4); }
            *(u32x4*)dp = pack8(x0 + m0 * v0, x1 + m1 * v1);
        EPI_LOOP_END
    }
};
struct EpiResPart {
    static constexpr bool PERM = true, AFTER_DRAIN = false, MID = false;
    const float* mod; int moff; float* part; int kslice;
    DI void operator()(const f32x4 (&acc)[2][2][4][2], const pg8::Unit& u, int wr, int wc, int fr, int fq) const {
        float* pb = part + (size_t)(u.kofs / kslice) * MS * D;
        EPI_LOOP_BEGIN
            const float* mg = mod + (size_t)seq_of_row(row) * 6144 + moff + col0;
            const f32x4 m0 = *(const f32x4*)mg, m1 = *(const f32x4*)(mg + 4);
            float* dp = pb + (size_t)(row - MP) * D + col0;
            *(f32x4*)dp = m0 * v0; *(f32x4*)(dp + 4) = m1 * v1;
        EPI_LOOP_END
    }
};
struct SliceOrder {
    int G, c, nslice, kslice, npn;
    DI bool next(int i, pg8::Unit& u) const {
        const int L = i * G + c, per = 2 * npn; if (L >= nslice * per) return false;
        const int ks = L / per, rem = L - ks * per; u.pm = MP / 256 + rem / npn; u.pn = rem % npn; u.kofs = ks * kslice; return true;
    }
    DI void a_ready(const pg8::Unit&) const {}
    DI void done(const pg8::Unit&) const {}
};
struct EpiSqrelu {
    static constexpr bool PERM = true, AFTER_DRAIN = false, MID = false;
    bf16_t* F;
    DI void operator()(const f32x4 (&acc)[2][2][4][2], const pg8::Unit& u, int wr, int wc, int fr, int fq) const {
        EPI_LOOP_BEGIN
            f32x4 a, b;
#pragma unroll
            for (int i = 0; i < 4; ++i) { const float p0 = fmaxf(v0[i], 0.f), p1 = fmaxf(v1[i], 0.f); a[i] = p0 * p0; b[i] = p1 * p1; }
            *(u32x4*)(F + (size_t)row * DFF + col0) = pack8(a, b);
        EPI_LOOP_END
    }
};

DI void transpose_item(const float* W, int N, bf16_t* WT, int opitch, int item, LAS float* scr, int tid) {
    const int ntn = N >> 6, kt = item / ntn, nt = item - kt * ntn;
    __syncthreads();
#pragma unroll
    for (int i = 0; i < 8; ++i) { const int e = tid + i * NTHREADS, r = e >> 6, c = e & 63; scr[r * 65 + c] = W[(size_t)(kt * 64 + r) * N + nt * 64 + c]; }
    __syncthreads();
#pragma unroll
    for (int i = 0; i < 8; ++i) { const int e = tid + i * NTHREADS, r = e >> 6, c = e & 63; WT[(size_t)(nt * 64 + r) * opitch + kt * 64 + c] = f2bf(scr[c * 65 + r]); }
}

DI void phase0(const Params& p, LAS unsigned char* lds, int tid, int bid, int nb) {
    unsigned char* ws = p.ws;
    LAS float* scr = (LAS float*)lds;
    int base = 0;
#define TRJOB2(Wp, Kd, Nd, off, opitch) do { const int nit = ((Kd) >> 6) * ((Nd) >> 6); const int first = (bid - (base % nb) + nb) % nb; \
        _Pragma("unroll 1") for (int it = first; it < nit; it += nb) transpose_item((Wp), (Nd), (bf16_t*)(ws + (off)), (opitch), it, scr, tid); base += nit; } while (0)
#define TRJOB(Wp, Kd, Nd, off) do { const int nit = ((Kd) >> 6) * ((Nd) >> 6); const int first = (bid - (base % nb) + nb) % nb; \
        _Pragma("unroll 1") for (int it = first; it < nit; it += nb) transpose_item((Wp), (Nd), (bf16_t*)(ws + (off)), (Kd), it, scr, tid); base += nit; } while (0)
    TRJOB(p.in[11], D, INPROJ, WS_WIN); TRJOB2(p.in[24], 512, D, WS_WBRR, D); TRJOB2(p.in[25], 512, D, WS_WBRR + 1024, D);
    TRJOB(p.in[26], D, D, WS_WOUT); TRJOB(p.in[28], D, DFF, WS_W1); TRJOB(p.in[29], DFF, D, WS_W2);
    TRJOB(p.in[13], 64, 512, WS_WUP); TRJOB(p.in[15], 64, 512, WS_AUP); TRJOB(p.in[17], 128, 512, WS_GUP);
#undef TRJOB
#undef TRJOB2
    {
        bf16_t* ks = (bf16_t*)(ws + WS_KS); bf16_t* vts = (bf16_t*)(ws + WS_VTS);
        const float* ck = p.in[6]; const float* cv = p.in[7];
        for (int e = bid * NTHREADS + tid; e < 16 * 512 * 128; e += nb * NTHREADS) {
            const int s_ = e >> 16, rem = e & 65535, j = rem >> 7, c4 = (rem & 127) * 4, hh = c4 >> 6, d = c4 & 63;
            const f32x4 v = *(const f32x4*)(ck + (size_t)s_ * 262144 + (size_t)rem * 4);
            u32x2 w; w.x = pk2(v[0], v[1]); w.y = pk2(v[2], v[3]);
            *(u32x2*)(ks + ((size_t)(s_ * 8 + hh) * 576 + j) * 64 + d) = w;
        }
#pragma unroll 1
        for (int it = bid; it < 16 * 8 * 8; it += nb) {
            const int sh = it >> 3, jt2 = it & 7, s_ = sh >> 3, hh = sh & 7;
            __syncthreads();
#pragma unroll
            for (int i = 0; i < 8; ++i) { const int e = tid + i * NTHREADS, j = e >> 6, d = e & 63; scr[j * 65 + d] = cv[(size_t)s_ * 262144 + (size_t)(jt2 * 64 + j) * 512 + hh * 64 + d]; }
            __syncthreads();
#pragma unroll
            for (int i = 0; i < 8; ++i) { const int e = tid + i * NTHREADS, half = e >> 11, d = (e >> 5) & 63, jj = e & 31;
                vts[(((size_t)sh * 18 + jt2 * 2 + half) * 64 + d) * 32 + jj] = f2bf(scr[(half * 32 + jj) * 65 + d]); }
        }
    }
    {
        __syncthreads();
        LAS float* sc = (LAS float*)lds;
        LAS float* part = (LAS float*)(lds + 98304);
        bool have = false;
#pragma unroll 1
        for (int un = bid; un < 192; un += nb) {
            if (!have) {
                for (int e = tid; e < NSEQ * D; e += NTHREADS) { const int s = e >> 10, k = e & 1023; const float c = s < 8 ? p.in[2][s * D + k] : p.in[3][(s - 8) * D + k]; sc[e] = c * sigmoidf_(c); }
                have = true;
            }
            __syncthreads();
            const int kg = tid >> 5, col = tid & 31, c0 = un * 32;
            float acc[NSEQ];
#pragma unroll
            for (int s = 0; s < NSEQ; ++s) acc[s] = 0.f;
            const float* wp = p.in[8] + (size_t)(kg * 64) * 6144 + c0 + col;
#pragma unroll 4
            for (int k = 0; k < 64; ++k) {
                const float w = wp[(size_t)k * 6144];
#pragma unroll
                for (int s = 0; s < NSEQ; ++s) acc[s] += sc[s * D + kg * 64 + k] * w;
            }
#pragma unroll
            for (int s = 0; s < NSEQ; ++s) { acc[s] += __shfl_xor(acc[s], 32); }
            const int wv = tid >> 6;
            if ((tid & 32) == 0) {
#pragma unroll
                for (int s = 0; s < NSEQ; ++s) part[(wv * NSEQ + s) * 32 + col] = acc[s];
            }
            __syncthreads();
            float* mod = (float*)(ws + WS_MOD);
            for (int e = tid; e < NSEQ * 32; e += NTHREADS) {
                const int s = e >> 5, c = e & 31; float v = p.in[9][c0 + c];
#pragma unroll
                for (int w8 = 0; w8 < 8; ++w8) v += part[(w8 * NSEQ + s) * 32 + c];
                mod[(size_t)s * 6144 + c0 + c] = v;
            }
        }
    }
}

DI void load_b16_row(const bf16_t* rp, int lane, f32x4 (&v)[4]) {
#pragma unroll
    for (int i = 0; i < 4; ++i) { const u32x2 w = *(const u32x2*)(rp + i * 256 + lane * 4); v[i] = (f32x4){lo_bf(w.x), hi_bf(w.x), lo_bf(w.y), hi_bf(w.y)}; }
}
template <int MODE>
DI void norm_phase(const Params& p, bf16_t* xb, const float* part, int npart, const float* g, int sh_off, int sc_off, bf16_t* dst, int gw, int nw, int lane) {
    const float* mod = (const float*)(p.ws + WS_MOD);
    constexpr int NR = 4;
#pragma unroll 1
    for (int row0 = gw; row0 < M; row0 += NR * nw) {
        f32x4 v[NR][4];
#pragma unroll
        for (int q = 0; q < NR; ++q) {
            const int row = min(row0 + q * nw, M - 1);
            if (MODE == 0 || (MODE == 1 && row >= MP)) {
                const float* xr = xrow_ptr(p, row);
#pragma unroll
                for (int i = 0; i < 4; ++i) v[q][i] = __builtin_nontemporal_load((const f32x4*)(xr + i * 256 + lane * 4));
            } else load_b16_row(xb + (size_t)row * D, lane, v[q]);
        }
#pragma unroll
        for (int q = 0; q < NR; ++q) {
            const int row = row0 + q * nw;
            if (row >= M) break;
            if (MODE != 0 && row >= MP) {
#pragma unroll 1
                for (int s_ = 0; s_ < npart; ++s_)
#pragma unroll
                    for (int i = 0; i < 4; ++i) v[q][i] += *(const f32x4*)(part + ((size_t)s_ * MS + (row - MP)) * D + i * 256 + lane * 4);
                if (MODE == 1) {
#pragma unroll
                    for (int i = 0; i < 4; ++i) { u32x2 w; w.x = pk2(v[q][i][0], v[q][i][1]); w.y = pk2(v[q][i][2], v[q][i][3]); *(u32x2*)(xb + (size_t)row * D + i * 256 + lane * 4) = w; }
                }
            }
            float ss = 0.f;
#pragma unroll
            for (int i = 0; i < 4; ++i) ss += v[q][i][0] * v[q][i][0] + v[q][i][1] * v[q][i][1] + v[q][i][2] * v[q][i][2] + v[q][i][3] * v[q][i][3];
            ss = wave_sum(ss);
            const float rstd = __builtin_amdgcn_rsqf(ss * (1.0f / D) + 1e-6f);
            if (MODE == 2) {
                float* yr = p.out + (size_t)row * D;
#pragma unroll
                for (int i = 0; i < 4; ++i) { const int c = i * 256 + lane * 4; __builtin_nontemporal_store((v[q][i] * rstd) * *(const f32x4*)(g + c), (f32x4*)(yr + c)); }
            } else {
                const float* mr = mod + (size_t)seq_of_row(row) * 6144;
#pragma unroll
                for (int i = 0; i < 4; ++i) {
                    const int c = i * 256 + lane * 4;
                    const f32x4 gg = *(const f32x4*)(g + c), sh = *(const f32x4*)(mr + sh_off + c), sc = *(const f32x4*)(mr + sc_off + c);
                    const f32x4 y = (v[q][i] * rstd) * gg * (sc + 1.0f) + sh;
                    u32x2 w; w.x = pk2(y[0], y[1]); w.y = pk2(y[2], y[3]);
                    *(u32x2*)(dst + (size_t)row * D + c) = w;
                }
            }
        }
    }
}

DI int crow(int r, int hi) { return (r & 3) + 8 * (r >> 2) + 4 * hi; }
DI void attn_unit(const bf16_t* Q, const bf16_t* K, const bf16_t* VT, int jh0, int jh1, int nq, bf16_t* Y, LAS const float* tab, int lane) {
    const int l32 = lane & 31, hi = lane >> 5;
    const int q0r = min(l32, nq - 1), q1r = min(32 + l32, nq - 1);
    f32x16 O[2][2];
#pragma unroll
    for (int a = 0; a < 2; ++a)
#pragma unroll
        for (int b = 0; b < 2; ++b)
#pragma unroll
            for (int i = 0; i < 16; ++i) O[a][b][i] = 0.f;
    float mrun[2] = {-1e30f, -1e30f}, lrun[2] = {0.f, 0.f};
    bf16x8 qf[2][4];
#pragma unroll
    for (int ks = 0; ks < 4; ++ks) { qf[0][ks] = *(const bf16x8*)(Q + q0r * 64 + ks * 16 + hi * 8); qf[1][ks] = *(const bf16x8*)(Q + q1r * 64 + ks * 16 + hi * 8); }
    bf16x8 kf[4];
#pragma unroll
    for (int ks = 0; ks < 4; ++ks) kf[ks] = *(const bf16x8*)(K + (ptrdiff_t)(jh0 * 32 + l32) * 64 + ks * 16 + hi * 8);
    bf16x8 vn[2][2];
#pragma unroll
    for (int db = 0; db < 2; ++db)
#pragma unroll
        for (int sub = 0; sub < 2; ++sub) {
            const bf16_t* vp = VT + (ptrdiff_t)jh0 * 2048 + (db * 32 + l32) * 32 + sub * 16 + 4 * hi;
            const u32x2 lo = *(const u32x2*)vp, hi2 = *(const u32x2*)(vp + 8);
            u32x4 w; w.x = lo.x; w.y = lo.y; w.z = hi2.x; w.w = hi2.y;
            vn[db][sub] = __builtin_bit_cast(bf16x8, w);
        }
#pragma unroll 1
    for (int jh = jh0; jh < jh1; ++jh) {
        f32x16 st[2];
#pragma unroll
        for (int i = 0; i < 16; ++i) { st[0][i] = 0.f; st[1][i] = 0.f; }
#pragma unroll
        for (int ks = 0; ks < 4; ++ks) {
            st[0] = MFMA32(kf[ks], qf[0][ks], st[0]);
            st[1] = MFMA32(kf[ks], qf[1][ks], st[1]);
        }
        {
            const int jn = min(jh + 1, jh1 - 1);
#pragma unroll
            for (int ks = 0; ks < 4; ++ks) kf[ks] = *(const bf16x8*)(K + (ptrdiff_t)(jn * 32 + l32) * 64 + ks * 16 + hi * 8);
        }
        bf16x8 vf[2][2];
#pragma unroll
        for (int db = 0; db < 2; ++db)
#pragma unroll
            for (int sub = 0; sub < 2; ++sub) vf[db][sub] = vn[db][sub];
        {
            const int jn = min(jh + 1, jh1 - 1);
#pragma unroll
            for (int db = 0; db < 2; ++db)
#pragma unroll
                for (int sub = 0; sub < 2; ++sub) {
                    const bf16_t* vp = VT + (ptrdiff_t)jn * 2048 + (db * 32 + l32) * 32 + sub * 16 + 4 * hi;
                    const u32x2 lo = *(const u32x2*)vp, hi2 = *(const u32x2*)(vp + 8);
                    u32x4 w; w.x = lo.x; w.y = lo.y; w.z = hi2.x; w.w = hi2.y;
                    vn[db][sub] = __builtin_bit_cast(bf16x8, w);
                }
        }
        bf16x8 pf[2][2];
#pragma unroll
        for (int qb = 0; qb < 2; ++qb) {
            const int qi = qb * 32 + l32;
            float mx = -1e30f;
#pragma unroll
            for (int i = 0; i < 16; ++i) {
                float sv = st[qb][i];
                if (jh >= 12) { const int dist = qi - (jh * 32 - 512 + crow(i, hi)); sv += tab[min(dist, 128) + 128]; }
                st[qb][i] = sv; mx = fmaxf(mx, sv);
            }
            mx = fmaxf(mx, __shfl_xor(mx, 32));
            const float mnew = fmaxf(mrun[qb], mx), alpha = __builtin_amdgcn_exp2f(mrun[qb] - mnew);
            mrun[qb] = mnew;
            float ps = 0.f;
#pragma unroll
            for (int i = 0; i < 16; ++i) { const float pv = __builtin_amdgcn_exp2f(st[qb][i] - mnew); st[qb][i] = pv; ps += pv; }
#pragma unroll
            for (int sub = 0; sub < 2; ++sub) {
                u32x4 w;
                w.x = pk2(st[qb][sub * 8 + 0], st[qb][sub * 8 + 1]); w.y = pk2(st[qb][sub * 8 + 2], st[qb][sub * 8 + 3]);
                w.z = pk2(st[qb][sub * 8 + 4], st[qb][sub * 8 + 5]); w.w = pk2(st[qb][sub * 8 + 6], st[qb][sub * 8 + 7]);
                pf[sub][qb] = __builtin_bit_cast(bf16x8, w);
            }
            lrun[qb] = lrun[qb] * alpha + ps;
            if (__builtin_amdgcn_ballot_w64(alpha != 1.0f) != 0ull) {
#pragma unroll
                for (int db = 0; db < 2; ++db)
#pragma unroll
                    for (int i = 0; i < 16; ++i) O[db][qb][i] *= alpha;
            }
        }
#pragma unroll
        for (int db = 0; db < 2; ++db)
#pragma unroll
            for (int sub = 0; sub < 2; ++sub) {
                O[db][0] = MFMA32(vf[db][sub], pf[sub][0], O[db][0]);
                O[db][1] = MFMA32(vf[db][sub], pf[sub][1], O[db][1]);
            }
    }
#pragma unroll
    for (int qb = 0; qb < 2; ++qb) {
        const float lt = lrun[qb] + __shfl_xor(lrun[qb], 32), inv = 1.0f / lt;
        const int q = qb * 32 + l32;
        if (q < nq) {
#pragma unroll
            for (int db = 0; db < 2; ++db)
#pragma unroll
                for (int g = 0; g < 4; ++g) {
                    u32x2 w; w.x = pk2(O[db][qb][4 * g] * inv, O[db][qb][4 * g + 1] * inv); w.y = pk2(O[db][qb][4 * g + 2] * inv, O[db][qb][4 * g + 3] * inv);
                    *(u32x2*)(Y + (size_t)q * 1024 + db * 32 + 8 * g + 4 * hi) = w;
                }
        }
    }
}

constexpr int TAB_BYTES = 8448;
constexpr int PW = 72, PG = 136;
struct PrepW { bf16x8 wf[2][4], af[2][4], gf[2][8]; };
DI void prep_load(const Params& p, PrepW& W, int wid, int lane) {
    const int l32 = lane & 31, hi = lane >> 5;
    const bf16_t* wup = (const bf16_t*)(p.ws + WS_WUP); const bf16_t* aup = (const bf16_t*)(p.ws + WS_AUP); const bf16_t* gup = (const bf16_t*)(p.ws + WS_GUP);
#pragma unroll
    for (int cb = 0; cb < 2; ++cb) {
        const int chr = wid * 64 + cb * 32 + l32;
#pragma unroll
        for (int ks = 0; ks < 4; ++ks) { W.wf[cb][ks] = *(const bf16x8*)(wup + (size_t)chr * 64 + ks * 16 + hi * 8); W.af[cb][ks] = *(const bf16x8*)(aup + (size_t)chr * 64 + ks * 16 + hi * 8); }
#pragma unroll
        for (int ks = 0; ks < 8; ++ks) W.gf[cb][ks] = *(const bf16x8*)(gup + (size_t)chr * 128 + ks * 16 + hi * 8);
    }
}
DI void prep_unit(const Params& p, const PrepW& W, int tile, LAS unsigned char* lds, int tid, int wid, int lane) {
    const bf16_t* pr = (const bf16_t*)(p.ws + WS_PR);
    LAS bf16_t* aW = (LAS bf16_t*)(lds + TAB_BYTES);
    LAS bf16_t* aA = aW + 64 * PW;
    LAS bf16_t* aG = aA + 64 * PW;
    LAS const float* lbias = (LAS const float*)(lds + TAB_BYTES + 36864);
    __syncthreads();
    {
        const int tid_o = opaque(tid);
        const int tok = tid_o >> 3, cgi = tid_o & 7, row = tile * 64 + tok, c0 = 1536 + cgi * 32;
        const bf16_t* cur = pr + (size_t)row * RPROJ + c0;
        int mode = 0;
        const float* sp = nullptr;
        if (row < MP) { if ((row & 8191) == 0) mode = 1; }
        else { const int sr = row - MP; if ((sr & 31) == 0) { mode = 2; sp = p.in[5] + (size_t)(sr >> 5) * RPROJ + c0; } }
        const float* mu = p.in[12] + c0;
#pragma unroll 2
        for (int q = 0; q < 4; ++q) {
            f32x4 c0v, c1v, p0v, p1v;
            unpack8(*(const u32x4*)(cur + q * 8), c0v, c1v);
            if (mode == 0) unpack8(*(const u32x4*)(cur - RPROJ + q * 8), p0v, p1v);
            else if (mode == 1) { p0v = (f32x4){0.f, 0.f, 0.f, 0.f}; p1v = p0v; }
            else { p0v = *(const f32x4*)(sp + q * 8); p1v = *(const f32x4*)(sp + q * 8 + 4); }
            const f32x4 m0 = *(const f32x4*)(mu + q * 8), m1 = *(const f32x4*)(mu + q * 8 + 4);
            f32x4 x0 = c0v + (p0v - c0v) * m0, x1 = c1v + (p1v - c1v) * m1;
            const int cc = cgi * 32 + q * 8;
            LAS bf16_t* dstp;
            if (cgi < 2) {
#pragma unroll
                for (int i = 0; i < 4; ++i) { x0[i] = 1.0f - 2.0f * __builtin_amdgcn_rcpf(__builtin_amdgcn_exp2f(2.0f * L2E * x0[i]) + 1.0f); x1[i] = 1.0f - 2.0f * __builtin_amdgcn_rcpf(__builtin_amdgcn_exp2f(2.0f * L2E * x1[i]) + 1.0f); }
                dstp = aW + tok * PW + cc;
            } else if (cgi < 4) { dstp = aA + tok * PW + (cc - 64); }
            else {
#pragma unroll
                for (int i = 0; i < 4; ++i) { x0[i] = sigmoidf_(x0[i]); x1[i] = sigmoidf_(x1[i]); }
                dstp = aG + tok * PG + (cc - 128);
            }
            *(LAS u32x4*)dstp = pack8(x0, x1);
        }
    }
    __syncthreads();
    const int l32 = lane & 31, hi = lane >> 5;
    bf16_t* abuf = (bf16_t*)p.out;
    bf16_t* ebuf = abuf + (size_t)M * 512;
    bf16_t* gbuf = ebuf + (size_t)M * 512;
#pragma unroll
    for (int lo = 0; lo < 3; ++lo) {
        const int Kd = lo == 2 ? 128 : 64;
        LAS const bf16_t* act = lo == 0 ? aW : lo == 1 ? aA : aG;
        const int pitch = lo == 2 ? PG : PW;
        bf16_t* obuf = lo == 0 ? ebuf : lo == 1 ? abuf : gbuf;
#pragma unroll
        for (int cb = 0; cb < 2; ++cb) {
            f32x16 acc[2];
#pragma unroll
            for (int i = 0; i < 16; ++i) { acc[0][i] = 0.f; acc[1][i] = 0.f; }
#pragma unroll
            for (int ks = 0; ks < Kd / 16; ++ks) {
                const bf16x8 af = lo == 0 ? W.wf[cb][ks & 3] : lo == 1 ? W.af[cb][ks & 3] : W.gf[cb][ks];
#pragma unroll
                for (int tb = 0; tb < 2; ++tb) {
                    const bf16x8 bfr = *(LAS const bf16x8*)(act + (tb * 32 + l32) * pitch + ks * 16 + hi * 8);
                    acc[tb] = MFMA32(af, bfr, acc[tb]);
                }
            }
#pragma unroll
            for (int tb = 0; tb < 2; ++tb) {
                const int row = tile * 64 + tb * 32 + l32;
#pragma unroll
                for (int g = 0; g < 4; ++g) {
                    const int ch = wid * 64 + cb * 32 + 8 * g + 4 * hi;
                    float o[4];
                    f32x4 bv = {0.f, 0.f, 0.f, 0.f};
                    if (lo < 2) bv = *(LAS const f32x4*)(lbias + lo * 512 + ch);
#pragma unroll
                    for (int i = 0; i < 4; ++i) {
                        float z = acc[tb][4 * g + i];
                        if (lo == 0) z = 0.6065306597f * sigmoidf_(z + bv[i]);
                        else if (lo == 1) z = sigmoidf_(z + bv[i]);
                        o[i] = z;
                    }
                    u32x2 w; w.x = pk2(o[0], o[1]); w.y = pk2(o[2], o[3]);
                    *(u32x2*)(obuf + (size_t)row * 512 + ch) = w;
                }
            }
        }
    }
}

constexpr int STG_TOK = 384;
struct ScanC { float mu_r, mu_k, mu_v, kkc, kac, rkc; };
constexpr int RAW_BYTES = 5 * 8 * 128;
DI void scan_prefetch8(const bf16_t* pr, const bf16_t* abuf, const bf16_t* ebuf, LAS unsigned char* raw, unsigned rbase, int h, int lane) {
    const unsigned tok = (unsigned)(lane >> 5), d = (unsigned)(lane & 31);
#pragma unroll
    for (int jp = 0; jp < 4; ++jp) {
        const unsigned row = rbase + 2u * jp + tok;
        const bf16_t* g0 = pr + (size_t)row * RPROJ + h * 64 + 2 * d;
        const size_t ai = (size_t)row * 512 + h * 64 + 2 * d;
        __builtin_amdgcn_global_load_lds((const unsigned*)g0, (LAS unsigned*)(raw + (0 * 4 + jp) * 256), 4, 0, 0);
        __builtin_amdgcn_global_load_lds((const unsigned*)(g0 + 512), (LAS unsigned*)(raw + (1 * 4 + jp) * 256), 4, 0, 0);
        __builtin_amdgcn_global_load_lds((const unsigned*)(g0 + 1024), (LAS unsigned*)(raw + (2 * 4 + jp) * 256), 4, 0, 0);
        __builtin_amdgcn_global_load_lds((const unsigned*)(abuf + ai), (LAS unsigned*)(raw + (3 * 4 + jp) * 256), 4, 0, 0);
        __builtin_amdgcn_global_load_lds((const unsigned*)(ebuf + ai), (LAS unsigned*)(raw + (4 * 4 + jp) * 256), 4, 0, 0);
    }
}
template <bool FROM_LDS>
DI void scan_stage8(const bf16_t* pr, const bf16_t* abuf, const bf16_t* ebuf, LAS const unsigned char* raw, float* rkb, LAS float* stg, unsigned rbase, int ch, int h, int lane, const ScanC& C, float& pvr, float& pvk, float& pvv) {
    if constexpr (FROM_LDS) { asm volatile("s_waitcnt vmcnt(0)" ::: "memory"); __builtin_amdgcn_wave_barrier(); }
#pragma unroll 2
    for (int j = 0; j < 8; ++j) {
        const unsigned row = rbase + (unsigned)j;
        float cr, ck, cv, a, e;
        if constexpr (FROM_LDS) {
            LAS const bf16_t* rp = (LAS const bf16_t*)raw + j * 64 + lane;
            cr = bf2f(rp[0]); ck = bf2f(rp[512]); cv = bf2f(rp[1024]); a = bf2f(rp[1536]); e = bf2f(rp[2048]);
        } else {
            const unsigned pi = row * (unsigned)RPROJ + (unsigned)ch, ai = row * 512u + (unsigned)ch;
            cr = bf2f(pr[pi]); ck = bf2f(pr[pi + 512u]); cv = bf2f(pr[pi + 1024u]); a = bf2f(abuf[ai]); e = bf2f(ebuf[ai]);
        }
        const float xr = cr + (pvr - cr) * C.mu_r, xk = ck + (pvk - ck) * C.mu_k, xv = cv + (pvv - cv) * C.mu_v;
        pvr = cr; pvk = ck; pvv = cv;
        const float w = __builtin_amdgcn_exp2f(-e * L2E);
        const float kv = xk * C.kkc;
        const float ss = wave_sum(kv * kv);
        const float kkn = kv * __builtin_amdgcn_rsqf(fmaxf(ss, 1e-24f));
        const float kp = xk * (1.0f + (a - 1.0f) * C.kac);
        const float rk = wave_sum(xr * kp * C.rkc);
        if (lane == 0) rkb[row * 8u + (unsigned)h] = rk;
        LAS float* s = stg + j * STG_TOK + lane;
        s[0] = w; s[64] = kkn; s[128] = kkn * a; s[192] = kp; s[256] = xr; s[320] = xv;
    }
    asm volatile("s_waitcnt lgkmcnt(0)" ::: "memory");
    __builtin_amdgcn_wave_barrier();
}

DI void scan_task(const Params& p, int task, LAS float* stg, LAS unsigned char* raw, int lane) {
    const bf16_t* pr = (const bf16_t*)(p.ws + WS_PR);
    const bf16_t* abuf = (const bf16_t*)p.out;
    const bf16_t* ebuf = abuf + (size_t)M * 512;
    bf16_t* qt = (bf16_t*)(p.ws + WS_QB);
    bf16_t* ol = (bf16_t*)(p.ws + WS_KB);
    float* rkb = (float*)(p.ws + WS_RK);
    const int b = task >> 8, c = (task >> 3) & 31, h = task & 7, row0 = b * TP + c * 256;
    float* Uout = (float*)(p.ws + WS_UBUF) + (size_t)((b * 8 + h) * 32 + c) * 4096;
    float* Pout = (float*)(p.ws + WS_PBUF) + (size_t)((b * 8 + h) * 32 + c) * 4096;
    f32x2 P2[2][16], U2[2][16];
    int lane_v = lane; asm volatile("" : "+v"(lane_v));
    const int ch = h * 64 + lane_v, kh = lane_v >> 5, r = lane_v & 31;
#pragma unroll
    for (int rs = 0; rs < 2; ++rs) {
        const float d = (float)(kh * 32 - r - 32 * rs);
#pragma unroll
        for (int jp = 0; jp < 16; ++jp) { P2[rs][jp].x = fmaxf(1.0f - fabsf(d + (float)(2 * jp)), 0.f); P2[rs][jp].y = fmaxf(1.0f - fabsf(d + (float)(2 * jp + 1)), 0.f); U2[rs][jp].x = 0.f; U2[rs][jp].y = 0.f; }
    }
    ScanC C{p.in[12][ch], p.in[12][512 + ch], p.in[12][1024 + ch], p.in[18][ch], p.in[19][ch], p.in[20][ch]};
    float pvr = 0.f, pvk = 0.f, pvv = 0.f;
    if (c != 0) { const bf16_t* q = pr + (size_t)(row0 - 1) * RPROJ + ch; pvr = bf2f(q[0]); pvk = bf2f(q[512]); pvv = bf2f(q[1024]); }
    scan_prefetch8(pr, abuf, ebuf, raw, (unsigned)row0, h, lane);
#pragma unroll 1
    for (int t0 = 0; t0 < 256; t0 += 8) {
        const unsigned rbase = (unsigned)(row0 + t0);
        scan_stage8<true>(pr, abuf, ebuf, raw, rkb, stg, rbase, ch, h, lane, C, pvr, pvk, pvv);
        if (t0 + 8 < 256) scan_prefetch8(pr, abuf, ebuf, raw, rbase + 8u, h, lane);
#pragma unroll 1
        for (int j = 0; j < 8; ++j) {
            LAS const float* s = stg + j * STG_TOK + kh * 32;
#define SB __builtin_amdgcn_sched_barrier(0)
#define LD4(off) (*(LAS const f32x4*)(s + (off)))
            f32x4 kkv[8];
#pragma unroll
            for (int i = 0; i < 8; ++i) kkv[i] = LD4(64 + i * 4);
            const float vi0 = stg[j * STG_TOK + 320 + r], vi1 = stg[j * STG_TOK + 352 + r];
            f32x4 wb_[2], ab_[2], kb_[2], rb_[2];
            wb_[0] = LD4(0); ab_[0] = LD4(128); kb_[0] = LD4(192); rb_[0] = LD4(256);
            SB;
            f32x2 sp0 = {0.f, 0.f}, sp1 = sp0, su0 = sp0, su1 = sp0;
#pragma unroll
            for (int i = 0; i < 8; ++i) {
                const f32x2 ka = {kkv[i][0], kkv[i][1]}, kb = {kkv[i][2], kkv[i][3]};
                sp0 += P2[0][2 * i] * ka; sp0 += P2[0][2 * i + 1] * kb; sp1 += P2[1][2 * i] * ka; sp1 += P2[1][2 * i + 1] * kb;
                su0 += U2[0][2 * i] * ka; su0 += U2[0][2 * i + 1] * kb; su1 += U2[1][2 * i] * ka; su1 += U2[1][2 * i + 1] * kb;
            }
            float sP0 = sp0.x + sp0.y, sP1 = sp1.x + sp1.y, sU0 = su0.x + su0.y, sU1 = su1.x + su1.y;
            sP0 += __shfl_xor(sP0, 32); sP1 += __shfl_xor(sP1, 32); sU0 += __shfl_xor(sU0, 32); sU1 += __shfl_xor(sU1, 32);
            const f32x2 sPP0 = {sP0, sP0}, sPP1 = {sP1, sP1}, sUU0 = {sU0, sU0}, sUU1 = {sU1, sU1}, vv0 = {vi0, vi0}, vv1 = {vi1, vi1};
            f32x2 op0 = {0.f, 0.f}, op1 = op0, ou0 = op0, ou1 = op0;
#pragma unroll
            for (int bt = 0; bt < 8; ++bt) {
                const int cb = bt & 1, nb_ = cb ^ 1;
                if (bt < 7) { wb_[nb_] = LD4((bt + 1) * 4); ab_[nb_] = LD4(128 + (bt + 1) * 4); kb_[nb_] = LD4(192 + (bt + 1) * 4); rb_[nb_] = LD4(256 + (bt + 1) * 4); }
                SB;
                const f32x4 w4 = wb_[cb], a4 = ab_[cb], kp4 = kb_[cb], r4 = rb_[cb];
                const f32x2 wa = {w4[0], w4[1]}, wb = {w4[2], w4[3]}, aa = {a4[0], a4[1]}, ab = {a4[2], a4[3]};
                const f32x2 ka = {kp4[0], kp4[1]}, kb = {kp4[2], kp4[3]}, ra = {r4[0], r4[1]}, rb = {r4[2], r4[3]};
                P2[0][2 * bt] = P2[0][2 * bt] * wa - sPP0 * aa;          P2[0][2 * bt + 1] = P2[0][2 * bt + 1] * wb - sPP0 * ab;
                P2[1][2 * bt] = P2[1][2 * bt] * wa - sPP1 * aa;          P2[1][2 * bt + 1] = P2[1][2 * bt + 1] * wb - sPP1 * ab;
                U2[0][2 * bt] = U2[0][2 * bt] * wa - sUU0 * aa + vv0 * ka; U2[0][2 * bt + 1] = U2[0][2 * bt + 1] * wb - sUU0 * ab + vv0 * kb;
                U2[1][2 * bt] = U2[1][2 * bt] * wa - sUU1 * aa + vv1 * ka; U2[1][2 * bt + 1] = U2[1][2 * bt + 1] * wb - sUU1 * ab + vv1 * kb;
                op0 += P2[0][2 * bt] * ra; op0 += P2[0][2 * bt + 1] * rb; op1 += P2[1][2 * bt] * ra; op1 += P2[1][2 * bt + 1] * rb;
                ou0 += U2[0][2 * bt] * ra; ou0 += U2[0][2 * bt + 1] * rb; ou1 += U2[1][2 * bt] * ra; ou1 += U2[1][2 * bt + 1] * rb;
                SB;
            }
#undef SB
#undef LD4
            float oP0 = op0.x + op0.y, oP1 = op1.x + op1.y, oU0 = ou0.x + ou0.y, oU1 = ou1.x + ou1.y;
            oP0 += __shfl_xor(oP0, 32); oP1 += __shfl_xor(oP1, 32); oU0 += __shfl_xor(oU0, 32); oU1 += __shfl_xor(oU1, 32);
            const unsigned oi = (rbase + (unsigned)j) * 512u + (unsigned)ch;
            qt[oi] = f2bf(kh ? oP1 : oP0);
            ol[oi] = f2bf(kh ? oU1 : oU0);
        }
        __builtin_amdgcn_wave_barrier();
    }
#pragma unroll
    for (int rs = 0; rs < 2; ++rs)
#pragma unroll
        for (int jp = 0; jp < 16; ++jp) {
            *(f32x2*)(Pout + (r + 32 * rs) * 64 + kh * 32 + 2 * jp) = P2[rs][jp];
            *(f32x2*)(Uout + (r + 32 * rs) * 64 + kh * 32 + 2 * jp) = U2[rs][jp];
        }
}

constexpr int MS_KK = 0, MS_R = 2176, MS_NB = 4352, MS_KP = 6528, MS_NBT = 8704, MS_KPT = 10752, MS_VT = 12800, MS_AN = 14848, MS_BM = 15872, MS_C1 = 16384, MS_C2 = 16896,
              MS_LINV = 17408, MS_GEND = 17920, MS_BYTES = 18176, MS_PITCH = 136;
static_assert(8 * MS_BYTES <= LDS_BYTES - 64, "MFMA scan LDS");
DI bf16x8 ldfrag(LAS const unsigned char* p0, LAS const unsigned char* p1) { const u32x2 a = *(LAS const u32x2*)p0, b = *(LAS const u32x2*)p1; u32x4 w; w.x = a.x; w.y = a.y; w.z = b.x; w.w = b.y; return __builtin_bit_cast(bf16x8, w); }
DI bf16x8 zsel(bf16x8 f, bool valid) { u32x4 w = __builtin_bit_cast(u32x4, f); if (!valid) { w.x = 0u; w.y = 0u; w.z = 0u; w.w = 0u; } return __builtin_bit_cast(bf16x8, w); }
DI bf16x8 pack_lo8(const f32x16& x) { u32x4 w; w.x = pk2(x[0], x[1]); w.y = pk2(x[2], x[3]); w.z = pk2(x[4], x[5]); w.w = pk2(x[6], x[7]); return __builtin_bit_cast(bf16x8, w); }
DI bf16x8 pack_hi8(const f32x16& x) { u32x4 w; w.x = pk2(x[8], x[9]); w.y = pk2(x[10], x[11]); w.z = pk2(x[12], x[13]); w.w = pk2(x[14], x[15]); return __builtin_bit_cast(bf16x8, w); }
template <bool SAMPLE> DI void scan_task_mfma(const Params& p, int task, LAS unsigned char* ms, int lane) {
    const bf16_t* pr = (const bf16_t*)(p.ws + WS_PR);
    const bf16_t* abuf = (const bf16_t*)p.out;
    const bf16_t* ebuf = abuf + (size_t)M * 512;
    bf16_t* qt = (bf16_t*)(p.ws + WS_QB);
    bf16_t* ol = (bf16_t*)(p.ws + WS_KB);
    float* rkb = (float*)(p.ws + WS_RK);
    int b = 0, c = 0, h, row0, ntok; float* Uout; float* Pout = nullptr; const float* init = nullptr; const float* shp = nullptr;
    if constexpr (!SAMPLE) { b = task >> 8; c = (task >> 3) & 31; h = task & 7; row0 = b * TP + c * 256; ntok = 256;
        Uout = (float*)(p.ws + WS_UBUF) + (size_t)((b * 8 + h) * 32 + c) * 4096; Pout = (float*)(p.ws + WS_PBUF) + (size_t)((b * 8 + h) * 32 + c) * 4096; }
    else { const int sq = task >> 3; h = task & 7; row0 = MP + sq * 32; ntok = 32;
        init = p.in[4] + (size_t)(sq * 8 + h) * 4096; Uout = p.out + OUT_SWKV + (size_t)(sq * 8 + h) * 4096; shp = p.in[5] + (size_t)sq * RPROJ; }
    constexpr int CT0 = SAMPLE ? 2 : 0;
    int lane_v = lane; asm volatile("" : "+v"(lane_v));
    const int ch = h * 64 + lane_v;
#define MS_LANES int lv_ = lane; asm volatile("" : "+v"(lv_)); const int l32 = lv_ & 31, hi = lv_ >> 5, l16 = lv_ & 15; const bool rowok = l32 < 16; (void)l16; (void)rowok;
    f32x16 YT[2][4];
    { MS_LANES
#pragma unroll
    for (int kt = 0; kt < 2; ++kt)
#pragma unroll
        for (int ct = 0; ct < 4; ++ct)
#pragma unroll
            for (int r = 0; r < 16; ++r) YT[kt][ct][r] = (!SAMPLE && ct < 2 && (32 * kt + crow(r, hi)) == (ct * 32 + l32)) ? 1.f : 0.f;
    if constexpr (SAMPLE) {
#pragma unroll
        for (int ct = 2; ct < 4; ++ct)
#pragma unroll
            for (int kt = 0; kt < 2; ++kt)
#pragma unroll
                for (int g = 0; g < 4; ++g) {
                    const f32x4 iv = *(const f32x4*)(init + ((ct & 1) * 32 + l32) * 64 + 32 * kt + 8 * g + 4 * hi);
                    YT[kt][ct][4 * g] = iv[0]; YT[kt][ct][4 * g + 1] = iv[1]; YT[kt][ct][4 * g + 2] = iv[2]; YT[kt][ct][4 * g + 3] = iv[3];
                }
    }
    }
    ScanC C{p.in[12][ch], p.in[12][512 + ch], p.in[12][1024 + ch], p.in[18][ch], p.in[19][ch], p.in[20][ch]};
    float pvr = 0.f, pvk = 0.f, pvv = 0.f;
    if constexpr (SAMPLE) { pvr = shp[ch]; pvk = shp[512 + ch]; pvv = shp[1024 + ch]; }
    else if (c != 0) { const bf16_t* q = pr + (size_t)(row0 - 1) * RPROJ + ch; pvr = bf2f(q[0]); pvk = bf2f(q[512]); pvv = bf2f(q[1024]); }
#pragma unroll 1
    for (int t0 = 0; t0 < ntok; t0 += 16) {
        const unsigned rbase = (unsigned)(row0 + t0);
        {
            int lane = lane_v; asm volatile("" : "+v"(lane));
            float E = 0.f, G = 1.f;
            bf16_t rr_[16], rk_[16], rv_[16], ra_[16], re_[16];
#pragma unroll
            for (int j = 0; j < 16; ++j) {
                const unsigned row = rbase + (unsigned)j;
                const unsigned pi = row * (unsigned)RPROJ + (unsigned)ch, ai = row * 512u + (unsigned)ch;
                rr_[j] = pr[pi]; rk_[j] = pr[pi + 512u]; rv_[j] = pr[pi + 1024u]; ra_[j] = abuf[ai]; re_[j] = ebuf[ai];
            }
            __builtin_amdgcn_sched_barrier(0);
#pragma unroll
            for (int jp = 0; jp < 8; ++jp) {
                float nbv[2], kpv[2], vv[2];
#pragma unroll
                for (int u = 0; u < 2; ++u) {
                    const int j = 2 * jp + u;
                    const unsigned row = rbase + (unsigned)j;
                    const float cr = bf2f(rr_[j]), ck = bf2f(rk_[j]), cv = bf2f(rv_[j]);
                    const float a = bf2f(ra_[j]), e = bf2f(re_[j]);
                    const float xr = cr + (pvr - cr) * C.mu_r, xk = ck + (pvk - ck) * C.mu_k, xv = cv + (pvv - cv) * C.mu_v;
                    pvr = cr; pvk = ck; pvv = cv;
                    const float Gm1 = G;
                    E += e;
                    G = __builtin_amdgcn_exp2f(-E * L2E);
                    const float Gi = __builtin_amdgcn_exp2f(E * L2E);
                    const float kv = xk * C.kkc;
                    const float ss = wave_sum(kv * kv);
                    const float kkn = kv * __builtin_amdgcn_rsqf(fmaxf(ss, 1e-24f));
                    const float kp = xk * (1.0f + (a - 1.0f) * C.kac);
                    const float rk = wave_sum(xr * kp * C.rkc);
                    if (lane == 0) rkb[row * 8u + (unsigned)h] = rk;
                    const float kkt = Gm1 * kkn, rt = G * xr, nb = -(kkn * a) * Gi, kpg = kp * Gi;
                    LAS bf16_t* rowp = (LAS bf16_t*)(ms + j * MS_PITCH) + lane;
                    rowp[MS_KK / 2] = f2bf(kkt); rowp[MS_R / 2] = f2bf(rt); rowp[MS_NB / 2] = f2bf(nb); rowp[MS_KP / 2] = f2bf(kpg);
                    nbv[u] = nb; kpv[u] = kpg; vv[u] = xv;
                }
                ((LAS unsigned*)(ms + MS_NBT))[lane * 8 + jp] = pk2(nbv[0], nbv[1]);
                ((LAS unsigned*)(ms + MS_KPT))[lane * 8 + jp] = pk2(kpv[0], kpv[1]);
                ((LAS unsigned*)(ms + MS_VT))[lane * 8 + jp] = pk2(vv[0], vv[1]);
            }
            ((LAS float*)(ms + MS_GEND))[lane] = G;
        }
        asm volatile("s_waitcnt lgkmcnt(0)" ::: "memory");
        __builtin_amdgcn_wave_barrier();
        {
            MS_LANES
            f32x16 an, bm, c1, c2;
#pragma unroll
            for (int r = 0; r < 16; ++r) { an[r] = 0.f; bm[r] = 0.f; c1[r] = 0.f; c2[r] = 0.f; }
#pragma unroll
            for (int s4 = 0; s4 < 4; ++s4) {
                const int off = l16 * MS_PITCH + (16 * s4 + 8 * hi) * 2;
                const bf16x8 akk = zsel(ldfrag(ms + MS_KK + off, ms + MS_KK + off + 8), rowok), ar = zsel(ldfrag(ms + MS_R + off, ms + MS_R + off + 8), rowok);
                const bf16x8 bnb = ldfrag(ms + MS_NB + off, ms + MS_NB + off + 8), bkp = ldfrag(ms + MS_KP + off, ms + MS_KP + off + 8);
                an = MFMA32(akk, bnb, an); bm = MFMA32(akk, bkp, bm); c1 = MFMA32(ar, bnb, c1); c2 = MFMA32(ar, bkp, c2);
            }
            if (rowok) {
#pragma unroll
                for (int r = 0; r < 8; ++r) {
                    const int tau = crow(r, hi);
                    const bool lt = l32 < tau, le = l32 <= tau;
                    ((LAS float*)(ms + MS_AN))[tau * 16 + l32] = lt ? an[r] : 0.f;
                    ((LAS bf16_t*)(ms + MS_BM))[tau * 16 + l32] = f2bf(lt ? bm[r] : 0.f);
                    ((LAS bf16_t*)(ms + MS_C1))[tau * 16 + l32] = f2bf(le ? c1[r] : 0.f);
                    ((LAS bf16_t*)(ms + MS_C2))[tau * 16 + l32] = f2bf(le ? c2[r] : 0.f);
                }
            }
        }
        asm volatile("s_waitcnt lgkmcnt(0)" ::: "memory");
        __builtin_amdgcn_wave_barrier();
        {
            MS_LANES
            float x[16];
#pragma unroll
            for (int t = 0; t < 16; ++t) {
                float acc = (t == l16) ? 1.f : 0.f;
#pragma unroll
                for (int q4 = 0; q4 * 4 < t; ++q4) {
                    const f32x4 av = *(LAS const f32x4*)(ms + MS_AN + (t * 16 + q4 * 4) * 4);
#pragma unroll
                    for (int i = 0; i < 4; ++i) if (q4 * 4 + i < t) acc += av[i] * x[q4 * 4 + i];
                }
                x[t] = acc;
            }
            if (lv_ < 16) {
#pragma unroll
                for (int t = 0; t < 16; ++t) ((LAS bf16_t*)(ms + MS_LINV))[t * 16 + lv_] = f2bf(x[t]);
            }
        }
        asm volatile("s_waitcnt lgkmcnt(0)" ::: "memory");
        __builtin_amdgcn_wave_barrier();
#pragma unroll
        for (int ct = CT0; ct < 4; ++ct) {
            asm volatile("" ::: "memory");
            MS_LANES
            const int offp = l16 * 32 + 8 * hi;
            const bf16x8 linvA = zsel(ldfrag(ms + MS_LINV + offp, ms + MS_LINV + offp + 16), rowok);
            const bf16x8 c1A = zsel(ldfrag(ms + MS_C1 + offp, ms + MS_C1 + offp + 16), rowok);
            bf16x8 bmA, c2A;
            if (ct >= 2) { bmA = zsel(ldfrag(ms + MS_BM + l16 * 32 + 16 * hi, ms + MS_BM + l16 * 32 + 16 * hi + 8), rowok);
                           c2A = zsel(ldfrag(ms + MS_C2 + l16 * 32 + 16 * hi, ms + MS_C2 + l16 * 32 + 16 * hi + 8), rowok); }
            bf16x8 yb[2][2];
#pragma unroll
            for (int kt = 0; kt < 2; ++kt) { yb[kt][0] = pack_lo8(YT[kt][ct]); yb[kt][1] = pack_hi8(YT[kt][ct]); }
            bf16x8 vtb;
            if (ct >= 2) vtb = ldfrag(ms + MS_VT + ((ct & 1) * 32 + l32) * 32 + 16 * hi, ms + MS_VT + ((ct & 1) * 32 + l32) * 32 + 16 * hi + 8);
            f32x16 rhs, o;
#pragma unroll
            for (int r = 0; r < 16; ++r) { rhs[r] = 0.f; o[r] = 0.f; }
#pragma unroll
            for (int kt = 0; kt < 2; ++kt)
#pragma unroll
                for (int s2 = 0; s2 < 2; ++s2) {
                    const int off = l16 * MS_PITCH + (32 * kt + 16 * s2 + 4 * hi) * 2;
                    const bf16x8 akk = zsel(ldfrag(ms + MS_KK + off, ms + MS_KK + off + 16), rowok), ar = zsel(ldfrag(ms + MS_R + off, ms + MS_R + off + 16), rowok);
                    rhs = MFMA32(akk, yb[kt][s2], rhs);
                    o = MFMA32(ar, yb[kt][s2], o);
                }
            if (ct >= 2) rhs = MFMA32(bmA, vtb, rhs);
            const bf16x8 rb = pack_lo8(rhs);
            f32x16 sa;
#pragma unroll
            for (int r = 0; r < 16; ++r) sa[r] = 0.f;
            sa = MFMA32(linvA, rb, sa);
            const bf16x8 sab = pack_lo8(sa);
            o = MFMA32(c1A, sab, o);
            if (ct >= 2) o = MFMA32(c2A, vtb, o);
            {
                bf16_t* dst = (ct < 2 ? qt : ol);
                const unsigned oi = (rbase + 4u * (unsigned)hi) * 512u + (unsigned)(h * 64 + (ct & 1) * 32 + l32);
#pragma unroll
                for (int r = 0; r < 8; ++r) dst[oi + (unsigned)((r & 3) + 8 * (r >> 2)) * 512u] = f2bf(o[r]);
            }
#pragma unroll
            for (int kt = 0; kt < 2; ++kt) {
                const int offk = (32 * kt + l32) * 32;
                const bf16x8 nbA = ldfrag(ms + MS_NBT + offk + 8 * hi, ms + MS_NBT + offk + 8 * hi + 16);
                YT[kt][ct] = MFMA32(nbA, sab, YT[kt][ct]);
                if (ct >= 2) { const bf16x8 kpA = ldfrag(ms + MS_KPT + offk + 16 * hi, ms + MS_KPT + offk + 16 * hi + 8); YT[kt][ct] = MFMA32(kpA, vtb, YT[kt][ct]); }
#pragma unroll
                for (int g = 0; g < 4; ++g) {
                    const f32x4 gv = *(LAS const f32x4*)(ms + MS_GEND + (32 * kt + 8 * g + 4 * hi) * 4);
#pragma unroll
                    for (int i = 0; i < 4; ++i) YT[kt][ct][4 * g + i] *= gv[i];
                }
            }
        }
        asm volatile("s_waitcnt lgkmcnt(0)" ::: "memory");
        __builtin_amdgcn_wave_barrier();
    }
    MS_LANES
#pragma unroll
    for (int ct = CT0; ct < 4; ++ct) {
        if (ct < 2) {
#pragma unroll
            for (int kt = 0; kt < 2; ++kt)
#pragma unroll
                for (int r = 0; r < 16; ++r) Pout[(32 * kt + crow(r, hi)) * 64 + (ct & 1) * 32 + l32] = YT[kt][ct][r];
        } else {
            float* dst = Uout + ((ct & 1) * 32 + l32) * 64;
#pragma unroll
            for (int kt = 0; kt < 2; ++kt)
#pragma unroll
                for (int g = 0; g < 4; ++g)
                    *(f32x4*)(dst + 32 * kt + 8 * g + 4 * hi) = (f32x4){YT[kt][ct][4 * g], YT[kt][ct][4 * g + 1], YT[kt][ct][4 * g + 2], YT[kt][ct][4 * g + 3]};
        }
    }
}

DI void scan_sample_task(const Params& p, int task, LAS float* stg, int lane) {
    const bf16_t* pr = (const bf16_t*)(p.ws + WS_PR);
    const bf16_t* abuf = (const bf16_t*)p.out;
    const bf16_t* ebuf = abuf + (size_t)M * 512;
    bf16_t* ol = (bf16_t*)(p.ws + WS_KB);
    float* rkb = (float*)(p.ws + WS_RK);
    const int sq = task >> 3, h = task & 7, row0 = MP + sq * 32;
    const float* init = p.in[4] + (size_t)(sq * 8 + h) * 4096;
    float* Uout = p.out + OUT_SWKV + (size_t)(sq * 8 + h) * 4096;
    const float* shp = p.in[5] + (size_t)sq * RPROJ;
    const int ch = h * 64 + lane;
    float U[64];
#pragma unroll
    for (int k4 = 0; k4 < 16; ++k4) {
        const f32x4 iv = *(const f32x4*)(init + lane * 64 + k4 * 4);
        U[k4 * 4] = iv[0]; U[k4 * 4 + 1] = iv[1]; U[k4 * 4 + 2] = iv[2]; U[k4 * 4 + 3] = iv[3];
    }
    ScanC C{p.in[12][ch], p.in[12][512 + ch], p.in[12][1024 + ch], p.in[18][ch], p.in[19][ch], p.in[20][ch]};
    float pvr = shp[ch], pvk = shp[512 + ch], pvv = shp[1024 + ch];
#pragma unroll 1
    for (int t0 = 0; t0 < 32; t0 += 8) {
        const unsigned rbase = (unsigned)(row0 + t0);
        scan_stage8<false>(pr, abuf, ebuf, nullptr, rkb, stg, rbase, ch, h, lane, C, pvr, pvk, pvv);
#pragma unroll 1
        for (int j = 0; j < 8; ++j) {
            LAS const float* s = stg + j * STG_TOK;
            float sa0 = 0.f, sa1 = 0.f;
#pragma unroll
            for (int k4 = 0; k4 < 16; ++k4) {
                const f32x4 kk4 = *(LAS const f32x4*)(s + 64 + k4 * 4);
                sa0 += U[k4 * 4 + 0] * kk4[0]; sa1 += U[k4 * 4 + 1] * kk4[1]; sa0 += U[k4 * 4 + 2] * kk4[2]; sa1 += U[k4 * 4 + 3] * kk4[3];
            }
            const float sa = sa0 + sa1;
            const float vi = s[320 + lane];
            float o0 = 0.f, o1 = 0.f;
#pragma unroll
            for (int k4 = 0; k4 < 16; ++k4) {
                const f32x4 w4 = *(LAS const f32x4*)(s + k4 * 4), a4 = *(LAS const f32x4*)(s + 128 + k4 * 4), kp4 = *(LAS const f32x4*)(s + 192 + k4 * 4), r4 = *(LAS const f32x4*)(s + 256 + k4 * 4);
#pragma unroll
                for (int i = 0; i < 4; ++i) U[k4 * 4 + i] = U[k4 * 4 + i] * w4[i] - sa * a4[i] + vi * kp4[i];
                o0 += U[k4 * 4 + 0] * r4[0]; o1 += U[k4 * 4 + 1] * r4[1]; o0 += U[k4 * 4 + 2] * r4[2]; o1 += U[k4 * 4 + 3] * r4[3];
            }
            ol[(rbase + (unsigned)j) * 512u + (unsigned)ch] = f2bf(o0 + o1);
        }
        __builtin_amdgcn_wave_barrier();
    }
#pragma unroll
    for (int k = 0; k < 64; ++k) Uout[lane * 64 + k] = U[k];
}

#define MFMA16F(a, b, c) __builtin_amdgcn_mfma_f32_16x16x4f32((a), (b), (c), 0, 0, 0)
DI void chunk_scan_task(const Params& p, int task, int lane) {
    const int bh = task >> 2, rb = task & 3, n = lane & 15, q = lane >> 4, v = rb * 16 + n;
    const float* Pb = (const float*)(p.ws + WS_PBUF) + (size_t)bh * 32 * 4096;
    const float* Ub = (const float*)(p.ws + WS_UBUF) + (size_t)bh * 32 * 4096;
    float* Sst = (float*)(p.ws + WS_SST) + (size_t)bh * 33 * 4096;
    f32x4 ST[4];
#pragma unroll
    for (int kt = 0; kt < 4; ++kt) ST[kt] = (f32x4){0.f, 0.f, 0.f, 0.f};
    f32x4 pa[4][4], pb[4][4], ua[4], ub[4];
#define CS_LOAD(P_, U_, cc) do { const float* Pc = Pb + (size_t)(cc) * 4096; const float* Uc = Ub + (size_t)(cc) * 4096; \
        _Pragma("unroll") for (int kt = 0; kt < 4; ++kt) { U_[kt] = *(const f32x4*)(Uc + v * 64 + 16 * kt + 4 * q); \
            _Pragma("unroll") for (int ib = 0; ib < 4; ++ib) P_[kt][ib] = *(const f32x4*)(Pc + (16 * kt + n) * 64 + 16 * ib + 4 * q); } } while (0)
#define CS_STEP(P_, U_, Pn_, Un_, cc) do { const int c_ = (cc); \
        if (c_ + 1 < 32) CS_LOAD(Pn_, Un_, c_ + 1); \
        f32x4 nw[4]; \
        _Pragma("unroll") for (int kt = 0; kt < 4; ++kt) { *(f32x4*)(Sst + (size_t)c_ * 4096 + v * 64 + 16 * kt + 4 * q) = ST[kt]; nw[kt] = U_[kt]; } \
        _Pragma("unroll") for (int ib = 0; ib < 4; ++ib) _Pragma("unroll") for (int r = 0; r < 4; ++r) \
            _Pragma("unroll") for (int kt = 0; kt < 4; ++kt) nw[kt] = MFMA16F(P_[kt][ib][r], ST[ib][r], nw[kt]); \
        _Pragma("unroll") for (int kt = 0; kt < 4; ++kt) ST[kt] = nw[kt]; \
    } while (0)
    CS_LOAD(pa, ua, 0);
#pragma unroll 1
    for (int c = 0; c < 32; c += 2) { CS_STEP(pa, ua, pb, ub, c); CS_STEP(pb, ub, pa, ua, c + 1); }
#undef CS_STEP
#undef CS_LOAD
#pragma unroll
    for (int kt = 0; kt < 4; ++kt) *(f32x4*)(p.out + OUT_PWKV + (size_t)bh * 4096 + v * 64 + 16 * kt + 4 * q) = ST[kt];
}

DI void post_rows(const Params& p, int row0, int h, const f32x16 (&acc)[2], int lane);
DI void post_chunk(const Params& p, int task, int lane) {
    const int l32 = lane & 31, hi = lane >> 5;
    const bf16_t* qt = (const bf16_t*)(p.ws + WS_QB);
    const int b = task >> 8, c = (task >> 3) & 31, h = task & 7;
    const float* Sp = (const float*)(p.ws + WS_SST) + (size_t)((b * 8 + h) * 33 + c) * 4096;
    bf16x8 af[2][4];
    if (c > 0) {
#pragma unroll
        for (int vb = 0; vb < 2; ++vb)
#pragma unroll
            for (int ks = 0; ks < 4; ++ks) {
                const float* sp = Sp + (vb * 32 + l32) * 64 + ks * 16 + hi * 8;
                af[vb][ks] = __builtin_bit_cast(bf16x8, pack8(*(const f32x4*)sp, *(const f32x4*)(sp + 4)));
            }
    }
#pragma unroll 1
    for (int tb = 0; tb < 8; ++tb) {
        const int row0 = b * TP + c * 256 + tb * 32;
        f32x16 acc[2];
#pragma unroll
        for (int i = 0; i < 16; ++i) { acc[0][i] = 0.f; acc[1][i] = 0.f; }
        if (c > 0) {
#pragma unroll
            for (int ks = 0; ks < 4; ++ks) {
                const bf16x8 bq = *(const bf16x8*)(qt + (size_t)(row0 + l32) * 512 + h * 64 + ks * 16 + hi * 8);
                acc[0] = MFMA32(af[0][ks], bq, acc[0]);
                acc[1] = MFMA32(af[1][ks], bq, acc[1]);
            }
        }
        post_rows(p, row0, h, acc, lane);
    }
}
DI void post_sample(const Params& p, int su, int lane) {
    f32x16 acc[2];
#pragma unroll
    for (int i = 0; i < 16; ++i) { acc[0][i] = 0.f; acc[1][i] = 0.f; }
    post_rows(p, MP + (su >> 3) * 32, su & 7, acc, lane);
}
DI void post_rows(const Params& p, int row0, int h, const f32x16 (&acc)[2], int lane) {
    const int l32 = lane & 31, hi = lane >> 5;
    const bf16_t* pr = (const bf16_t*)(p.ws + WS_PR);
    const bf16_t* ol = (const bf16_t*)(p.ws + WS_KB);
    const bf16_t* gbuf = (const bf16_t*)p.out + (size_t)2 * M * 512;
    const float* rkb = (const float*)(p.ws + WS_RK);
    bf16_t* yr = (bf16_t*)(p.ws + WS_YR);
    const int row = row0 + l32;
    float o[2][16]; float sum = 0.f;
#pragma unroll
    for (int vb = 0; vb < 2; ++vb)
#pragma unroll
        for (int g = 0; g < 4; ++g) {
            const u32x2 w = *(const u32x2*)(ol + (size_t)row * 512 + h * 64 + vb * 32 + 8 * g + 4 * hi);
            o[vb][4 * g + 0] = acc[vb][4 * g + 0] + lo_bf(w.x); o[vb][4 * g + 1] = acc[vb][4 * g + 1] + hi_bf(w.x);
            o[vb][4 * g + 2] = acc[vb][4 * g + 2] + lo_bf(w.y); o[vb][4 * g + 3] = acc[vb][4 * g + 3] + hi_bf(w.y);
            sum += (o[vb][4 * g] + o[vb][4 * g + 1]) + (o[vb][4 * g + 2] + o[vb][4 * g + 3]);
        }
    sum += __shfl_xor(sum, 32);
    const float mean = sum * (1.0f / 64.0f);
    float var = 0.f;
#pragma unroll
    for (int vb = 0; vb < 2; ++vb)
#pragma unroll
        for (int i = 0; i < 16; ++i) { const float d = o[vb][i] - mean; var += d * d; }
    var += __shfl_xor(var, 32);
    const float rstd = __builtin_amdgcn_rsqf(var * (1.0f / 64.0f) + 64e-5f);
    const float rk = rkb[(size_t)row * 8 + h];
    int mode = 0; const float* sp = nullptr;
    if (row < MP) { if ((row & 8191) == 0) mode = 1; }
    else { const int sr = row - MP; if ((sr & 31) == 0) { mode = 2; sp = p.in[5] + (size_t)(sr >> 5) * RPROJ + 1024; } }
#pragma unroll
    for (int vb = 0; vb < 2; ++vb)
#pragma unroll
        for (int g = 0; g < 4; ++g) {
            const int chn = h * 64 + vb * 32 + 8 * g + 4 * hi;
            const u32x2 cv = *(const u32x2*)(pr + (size_t)row * RPROJ + 1024 + chn);
            f32x4 c4 = {lo_bf(cv.x), hi_bf(cv.x), lo_bf(cv.y), hi_bf(cv.y)}, p4;
            if (mode == 0) { const u32x2 pv = *(const u32x2*)(pr + (size_t)(row - 1) * RPROJ + 1024 + chn); p4 = (f32x4){lo_bf(pv.x), hi_bf(pv.x), lo_bf(pv.y), hi_bf(pv.y)}; }
            else if (mode == 1) p4 = (f32x4){0.f, 0.f, 0.f, 0.f};
            else p4 = *(const f32x4*)(sp + chn);
            const f32x4 mu = *(const f32x4*)(p.in[12] + 1024 + chn);
            const f32x4 xv = c4 + (p4 - c4) * mu;
            const f32x4 lg = *(const f32x4*)(p.in[21] + chn), lb = *(const f32x4*)(p.in[22] + chn);
            const u32x2 gw = *(const u32x2*)(gbuf + (size_t)row * 512 + chn);
            const f32x4 gg = {lo_bf(gw.x), hi_bf(gw.x), lo_bf(gw.y), hi_bf(gw.y)};
            f32x4 y;
#pragma unroll
            for (int i = 0; i < 4; ++i) y[i] = ((o[vb][4 * g + i] - mean) * rstd * lg[i] + lb[i] + rk * xv[i]) * gg[i];
            u32x2 w; w.x = pk2(y[0], y[1]); w.y = pk2(y[2], y[3]);
            *(u32x2*)(yr + (size_t)row * 1024 + chn) = w;
        }
}

#ifndef PH_MASK
#define PH_MASK 0xffffffffu
#endif
#define PH(k) ((PH_MASK >> (k)) & 1u)
#ifndef DUP_MASK
#define DUP_MASK 0u
#endif
#define REP(k) _Pragma("unroll 1") for (int rep_ = 0; rep_ < (((DUP_MASK >> (k)) & 1u) ? 2 : 1); ++rep_)
__global__ void __launch_bounds__(NTHREADS, 2) fwd_megakernel(Params p) {
    extern __shared__ __attribute__((aligned(16))) unsigned char lds_raw[];
    LAS unsigned char* lds = (LAS unsigned char*)lds_raw;
    cg::grid_group grid = cg::this_grid();
    const int wid = __builtin_amdgcn_readfirstlane((int)threadIdx.x >> 6);
    const int nb = gridDim.x, bid = blockIdx.x;
    const int vcu = (nb % 8 == 0) ? (bid % 8) * (nb / 8) + bid / 8 : bid;
    const int gw = vcu * NWAVES + wid, nw = nb * NWAVES;
    unsigned char* ws = p.ws;
    volatile LAS unsigned* bst = (volatile LAS unsigned*)(lds + LDS_BYTES - 64);
    { const int t_ = wid * 64 + lane_now(); if (t_ < 16) bst[t_] = 0u; }
    __syncthreads();
    XcdBarrier xbar = xcd_barrier_post((unsigned*)(ws + WS_BAR), bst); xbar.w0 = wid;
#define GRID_BAR() xcd_barrier(xbar)

    REP(0) if (PH(0)) phase0(p, lds, wid * 64 + lane_now(), bid, nb);
    if (nb == 0x7fffffff) grid.sync();
    GRID_BAR();
    REP(1) if (PH(1)) norm_phase<0>(p, nullptr, nullptr, 0, p.in[10], 0, 1024, (bf16_t*)(ws + WS_ACTA), gw, nw, lane_now());
    GRID_BAR();
    REP(2) if (PH(2)) {
        pg8::Gemm g{(const bf16_t*)(ws + WS_ACTA), (const bf16_t*)(ws + WS_WIN), M, INPROJ, D, D};
        pg8::StaticOrder S; S.init(M, INPROJ, nb, vcu);
        EpiProj E{(bf16_t*)(ws + WS_PR), (bf16_t*)(ws + WS_QB), (bf16_t*)(ws + WS_KB), (bf16_t*)(ws + WS_VT), (bf16_t*)(ws + WS_GATES), (bf16_t*)(ws + WS_KS), (bf16_t*)(ws + WS_VTS), p.out};
        pg8::gemm_phase<EpiProj, pg8::StaticOrder, true, true>(lds, g, S, E, wid);
    }
    GRID_BAR();
    REP(3) if (PH(3)) {
        const int lane = lane_now(), tid = wid * 64 + lane;
        LAS float* tab = (LAS float*)lds;
        for (int e = tid; e < 8 * 257; e += NTHREADS) tab[e] = (p.in[23][e] - p.in[23][(e / 257) * 257 + 256]) * L2E;
        __syncthreads();
        const bf16_t* qb = (const bf16_t*)(ws + WS_QB); const bf16_t* kb = (const bf16_t*)(ws + WS_KB); const bf16_t* vt = (const bf16_t*)(ws + WS_VT);
        bf16_t* ya = (bf16_t*)(ws + WS_YR) + 512;
        const int h = wid;
        const int per = (1024 + nb - 1) / nb;
#pragma unroll 1
        for (int i = 0; i < per; ++i) {
            const int un = vcu * per + i;
            if (un < 1024) {
                const int b = un >> 7, c = un & 127;
                const size_t row0 = (size_t)b * TP + (size_t)c * 64;
                const int jh0 = c >= 8 ? 0 : 2 * (8 - c);
                const size_t bh = (size_t)(b * 8 + h);
                attn_unit(qb + (bh * 8192 + (size_t)c * 64) * 64, kb + ((ptrdiff_t)(bh * 8192) + (ptrdiff_t)c * 64 - 512) * 64, vt + ((ptrdiff_t)(bh * 256) + 2 * c - 16) * 2048, jh0, 18, 64,
                          ya + row0 * 1024 + h * 64, tab + h * 257, lane);
            }
        }
#pragma unroll 1
        for (int s = nb - 1 - vcu; s < 16; s += nb) {
            const size_t row0 = (size_t)MP + (size_t)s * 32;
            const size_t sh = (size_t)(s * 8 + h);
            attn_unit(qb + (size_t)MP * 512 + sh * 32 * 64, (const bf16_t*)(ws + WS_KS) + sh * 576 * 64, (const bf16_t*)(ws + WS_VTS) + sh * 18 * 2048, 0, 17, 32,
                      ya + row0 * 1024 + h * 64, tab + h * 257, lane);
        }
#ifndef NO_PREP
        {
            const int lane = lane_now(), tid = wid * 64 + lane;
            {
                LAS float* lb = (LAS float*)(lds + TAB_BYTES + 36864);
                for (int e = tid; e < 1024; e += NTHREADS) lb[e] = e < 512 ? p.in[14][e] : p.in[16][e - 512];
            }
            PrepW W; prep_load(p, W, wid, lane);
            const int npb = nb > 32 ? nb - 16 : nb;
            if (vcu < npb) {
#pragma unroll 1
                for (int tile = vcu; tile < M / 64; tile += npb) prep_unit(p, W, tile, lds, tid, wid, lane);
            }
        }
#endif
    }
    GRID_BAR();
    REP(4) if (PH(4)) {
        const int lane = lane_now();
#pragma unroll 1
        for (int task = gw; task < 2048; task += nw) scan_task_mfma<false>(p, task, lds + wid * MS_BYTES, lane);
    }
    GRID_BAR();
    REP(5) if (PH(5)) {
        const int lane = lane_now();
        if (wid == 0) {
#pragma unroll 1
            for (int task = vcu; task < 256; task += nb) chunk_scan_task(p, task, lane);
        } else if (wid == 1) {
#pragma unroll 1
            for (int task = vcu; task < 128; task += nb) scan_task_mfma<true>(p, task, lds + wid * MS_BYTES, lane);
        }
    }
    GRID_BAR();
    REP(6) if (PH(6)) {
        const int lane = lane_now();
#pragma unroll 1
        for (int task = gw; task < 2048; task += nw) post_chunk(p, task, lane);
#pragma unroll 1
        for (int su = nw - 1 - gw; su < 128; su += nw) post_sample(p, su, lane);
    }
    GRID_BAR();
    REP(7) if (PH(7)) {
        pg8::StaticOrder S; S.init(M, D, nb, vcu);
        pg8::Gemm g{(const bf16_t*)(ws + WS_YR), (const bf16_t*)(ws + WS_WBRR), M, D, D, D};
        EpiMerge E{(const bf16_t*)(ws + WS_GATES), (bf16_t*)(ws + WS_ACTA)};
        pg8::gemm_phase<EpiMerge, pg8::StaticOrder, true, true>(lds, g, S, E, wid);
    }
    GRID_BAR();
    REP(9) if (PH(9)) {
        {
            pg8::Gemm g{(const bf16_t*)(ws + WS_ACTA), (const bf16_t*)(ws + WS_WOUT), MP, D, D, D};
            pg8::StaticOrder S; S.init(MP, D, nb, vcu);
            EpiResB16 E{p.in[0], (const float*)(ws + WS_MOD), 2048, (bf16_t*)(ws + WS_YR), false};
            pg8::gemm_phase<EpiResB16, pg8::StaticOrder, true, true>(lds, g, S, E, wid);
        }
        {
            pg8::Gemm g{(const bf16_t*)(ws + WS_ACTA), (const bf16_t*)(ws + WS_WOUT), M, D, 256, D};
            SliceOrder S{nb, vcu, 4, 256, 4};
            EpiResPart E{(const float*)(ws + WS_MOD), 2048, (float*)(ws + WS_PART1), 256};
            pg8::gemm_phase<EpiResPart, SliceOrder, false, true>(lds, g, S, E, wid);
        }
    }
    GRID_BAR();
    REP(10) if (PH(10)) norm_phase<1>(p, (bf16_t*)(ws + WS_YR), (const float*)(ws + WS_PART1), 4, p.in[27], 3072, 4096, (bf16_t*)(ws + WS_ACTA), gw, nw, lane_now());
    GRID_BAR();
    REP(11) if (PH(11)) {
        pg8::Gemm g{(const bf16_t*)(ws + WS_ACTA), (const bf16_t*)(ws + WS_W1), M, DFF, D, D};
        pg8::StaticOrder S; S.init(M, DFF, nb, vcu);
        EpiSqrelu E{(bf16_t*)(ws + WS_PR)};
        pg8::gemm_phase<EpiSqrelu, pg8::StaticOrder, true, true>(lds, g, S, E, wid);
    }
    GRID_BAR();
    if (PH(12)) {
        {
            pg8::Gemm g{(const bf16_t*)(ws + WS_PR), (const bf16_t*)(ws + WS_W2), MP, D, DFF, DFF};
            pg8::StaticOrder S; S.init(MP, D, nb, vcu);
            EpiResB16 E{nullptr, (const float*)(ws + WS_MOD), 5120, (bf16_t*)(ws + WS_YR), true};
            pg8::gemm_phase<EpiResB16, pg8::StaticOrder, true, true>(lds, g, S, E, wid);
        }
        {
            pg8::Gemm g{(const bf16_t*)(ws + WS_PR), (const bf16_t*)(ws + WS_W2), M, D, 512, DFF};
            SliceOrder S{nb, vcu, 8, 512, 4};
            EpiResPart E{(const float*)(ws + WS_MOD), 5120, (float*)(ws + WS_PART2), 512};
            pg8::gemm_phase<EpiResPart, SliceOrder, false, true>(lds, g, S, E, wid);
        }
    }
    GRID_BAR();
    if (PH(13)) norm_phase<2>(p, (bf16_t*)(ws + WS_YR), (const float*)(ws + WS_PART2), 8, p.in[30], 0, 0, nullptr, gw, nw, lane_now());
}

extern "C" void kernel_launch(void* const* d_in, const int* in_sizes, int n_in, void* d_out, int out_size, void* d_ws, size_t ws_size, hipStream_t stream) {
    static int grid = 0;
    if (grid == 0) {
        if (n_in != 31 || ws_size < WS_END || out_size != 73181184) { fprintf(stderr, "kernel_launch: unexpected shapes (n_in %d, ws %zu, out %d)\n", n_in, ws_size, out_size); grid = -1; return; }
        int dev = 0, cus = 0, per_cu = 0;
        hipGetDevice(&dev);
        hipDeviceGetAttribute(&cus, hipDeviceAttributeMultiprocessorCount, dev);
        if (hipFuncSetAttribute((const void*)fwd_megakernel, hipFuncAttributeMaxDynamicSharedMemorySize, LDS_BYTES) != hipSuccess) { fprintf(stderr, "hipFuncSetAttribute failed\n"); grid = -1; return; }
        if (hipOccupancyMaxActiveBlocksPerMultiprocessor(&per_cu, (const void*)fwd_megakernel, NTHREADS, LDS_BYTES) != hipSuccess || per_cu < 1) { fprintf(stderr, "occupancy query failed (%d)\n", per_cu); per_cu = 1; }
        (void)hipGetLastError();
        grid = cus * per_cu;
    }
    if (grid < 0) return;
    if (hipMemsetAsync((char*)d_ws + WS_BAR, 0, WS_BAR_BYTES, stream) != hipSuccess) { fprintf(stderr, "kernel_launch: memset of the barrier words failed\n"); return; }
    Params p{};
    for (int i = 0; i < 31; ++i) p.in[i] = (const float*)d_in[i];
    p.out = (float*)d_out; p.ws = (unsigned char*)d_ws;
    void* args[] = {&p};
    hipError_t e = hipLaunchCooperativeKernel((const void*)fwd_megakernel, dim3(grid), dim3(NTHREADS), args, LDS_BYTES, stream);
    if (e != hipSuccess) fprintf(stderr, "cooperative launch failed: %s (grid %d)\n", hipGetErrorString(e), grid);
}
```

```cpp
#include <hip/hip_runtime.h>
#include <hip/hip_cooperative_groups.h>
#include <cstdio>
#include <cstdint>
namespace cg = cooperative_groups;
namespace pg8 {
#define PG8_LAS __attribute__((address_space(3)))
typedef unsigned short bf16_t;
typedef short bf16x8 __attribute__((ext_vector_type(8)));
typedef float f32x4 __attribute__((ext_vector_type(4)));
typedef unsigned u32x4 __attribute__((ext_vector_type(4)));
constexpr int BM = 256, BK = 64, HALF = 128, HTB = HALF * BK * 2  , STAGE_BYTES = 8 * HTB, NXCD = 8, WGM = 8;

__host__ __device__ __forceinline__ int lds_byte(int r, int c) { const int st = (r >> 4) * 2 + (c >> 5), rr = r & 15, cc = c & 31, ob = rr * 64 + cc * 2; return st * 1024 + (ob ^ (((ob >> 9) & 1) << 5)); }
__host__ __device__ __forceinline__ void stage_rc(int b, int& R, int& C) { const int st = b / 1024, sb = b % 1024, swz = sb ^ (((sb >> 9) & 1) << 5); R = (st >> 1) * 16 + swz / 64; C = (st & 1) * 32 + (swz % 64) / 2; }
__host__ __device__ __forceinline__ int perm32(int rho) { const int n = rho >> 4, i = rho & 15; return 8 * (i >> 2) + 4 * n + (i & 3); }

struct Unit { int pm, pn, kofs; };
struct Gemm { const bf16_t* A; const bf16_t* Bt; int M, N, K, ld; };

struct StaticOrder {
    int nM, nN, nwg, G, c;
    __host__ __device__ void init(int M, int N, int G_, int c_) { nM = M / BM; nN = N / BM; nwg = nM * nN; G = G_; c = c_; }
    __host__ __device__ bool next(int i, Unit& u) const {
        const long L = (long)i * G + c; if (L >= nwg) return false;
        int wgid = (int)L; { const int q = nwg / NXCD, r = nwg % NXCD, xcd = wgid % NXCD, off = wgid / NXCD; wgid = (xcd < r ? xcd * (q + 1) : r * (q + 1) + (xcd - r) * q) + off; }
        const int nig = WGM * nN, gid = wgid / nig, fm = gid * WGM, gsz = (nM - fm) < WGM ? (nM - fm) : WGM;
        u.pm = fm + ((wgid % nig) % gsz); u.pn = (wgid % nig) / gsz; u.kofs = 0; return true;
    }
    __device__ __forceinline__ void a_ready(const Unit&) const {}
    __device__ __forceinline__ void done(const Unit&) const {}
};

__device__ __forceinline__ unsigned cvt_pk_bf16(float lo, float hi) { unsigned r; asm volatile("v_cvt_pk_bf16_f32 %0, %1, %2" : "=v"(r) : "v"(lo), "v"(hi)); return r; }
template <class Epi, class Sched, bool ALIGN_EPI = false, bool SP2 = false>
__device__ __forceinline__ void gemm_phase(PG8_LAS unsigned char* lds, const Gemm g, const Sched& S, const Epi& E, const int wid_in) {
    int tid_; asm volatile("v_mbcnt_lo_u32_b32 %0, -1, 0\n\tv_mbcnt_hi_u32_b32 %0, -1, %0" : "=v"(tid_)); tid_ += wid_in * 64;
    const int tid = tid_, wid = __builtin_amdgcn_readfirstlane(tid >> 6), lane = tid & 63, wr = wid >> 2, wc = wid & 3, fr = lane & 15, fq = lane >> 4;
    const int K = g.K, nt = K / BK;
    unsigned voffA[2], voffB[2];
#pragma unroll
    for (int i = 0; i < 2; ++i) { int R, C; stage_rc(tid * 16 + i * 8192, R, C); const int Rb = Epi::PERM ? ((R & ~31) + perm32(R & 31)) : R;
        voffA[i] = (unsigned)(R * g.ld + C) * 2u; voffB[i] = (unsigned)(Rb * g.ld + C) * 2u; }
    const size_t kstep = (size_t)(BK * 2);
    const size_t hstep = (size_t)HALF * g.ld * 2;
    const size_t tstep = 2 * hstep;
    const unsigned ldsw = (unsigned)wid * 1024u;
    const int aoff = lds_byte(wr * 64 + fr, fq * 8), boff = lds_byte(wc * 32 + fr, fq * 8);
#define PG8_SA(b, h) (((b) * 2 + (h)) * HTB)
#define PG8_SB(b, h) ((4 + (b) * 2 + (h)) * HTB)
#define PG8_STAGE(bufoff, gbase, voff) do { _Pragma("unroll") for (int _i = 0; _i < 2; ++_i) \
        __builtin_amdgcn_global_load_lds((const unsigned*)((const char*)(gbase) + (voff)[_i]), (PG8_LAS unsigned*)(lds + (bufoff) + ldsw + _i * 8192), 16, 0, 0); } while (0)
#define PG8_LDA(dst, b, h) do { _Pragma("unroll") for (int m = 0; m < 4; ++m) _Pragma("unroll") for (int k = 0; k < 2; ++k) dst[m][k] = *(const PG8_LAS bf16x8*)(lds + PG8_SA(b, h) + aoff + m * 2048 + k * 1024); } while (0)
#define PG8_LDB(dst, b, h) do { _Pragma("unroll") for (int n = 0; n < 2; ++n) _Pragma("unroll") for (int k = 0; k < 2; ++k) dst[n][k] = *(const PG8_LAS bf16x8*)(lds + PG8_SB(b, h) + boff + n * 2048 + k * 1024); } while (0)
#define PG8_MMA(ai, bj, At, Bt) do { __builtin_amdgcn_s_setprio(1); _Pragma("unroll") for (int m = 0; m < 4; ++m) _Pragma("unroll") for (int n = 0; n < 2; ++n) _Pragma("unroll") for (int k = 0; k < 2; ++k) \
        acc[ai][bj][m][n] = __builtin_amdgcn_mfma_f32_16x16x32_bf16(Bt[n][k], At[m][k], acc[ai][bj][m][n], 0, 0, 0); __builtin_amdgcn_s_setprio(0); } while (0)
#define PG8_WAIT_V(n) asm volatile("s_waitcnt vmcnt(" #n ")" ::: "memory")
#define PG8_WAIT_L(n) asm volatile("s_waitcnt lgkmcnt(" #n ")" ::: "memory")
#define PG8_BAR __builtin_amdgcn_s_barrier()
#define PG8_SCHED __builtin_amdgcn_sched_barrier(0)
    Unit cur, nxt; int ui = 0;
    if (!S.next(0, cur)) return;
    f32x4 acc[2][2][4][2];
#pragma unroll
    for (int a = 0; a < 2; ++a)
#pragma unroll
        for (int b = 0; b < 2; ++b)
#pragma unroll
            for (int m = 0; m < 4; ++m)
#pragma unroll
                for (int n = 0; n < 2; ++n) acc[a][b][m][n] = (f32x4){0.f, 0.f, 0.f, 0.f};
    bf16x8 At[4][2], B0[2][2], B1[2][2];
    const char* cA = (const char*)g.A + (size_t)cur.pm * tstep + (size_t)cur.kofs * 2; const char* cB = (const char*)g.Bt + (size_t)cur.pn * tstep + (size_t)cur.kofs * 2;
    S.a_ready(cur);
    if constexpr (SP2) {
        PG8_STAGE(PG8_SB(0, 0), cB, voffB); PG8_STAGE(PG8_SB(0, 1), cB + hstep, voffB); PG8_STAGE(PG8_SA(0, 0), cA, voffA); PG8_STAGE(PG8_SA(0, 1), cA + hstep, voffA);
        if (wr == 1) PG8_BAR;
        PG8_WAIT_V(2); PG8_BAR;
        PG8_STAGE(PG8_SB(1, 0), cB + kstep, voffB); PG8_STAGE(PG8_SA(1, 0), cA + kstep, voffA); PG8_STAGE(PG8_SB(1, 1), cB + hstep + kstep, voffB);
        PG8_WAIT_V(6); PG8_BAR;
    } else {
        PG8_STAGE(PG8_SB(0, 0), cB, voffB); PG8_STAGE(PG8_SA(0, 0), cA, voffA); PG8_STAGE(PG8_SB(0, 1), cB + hstep, voffB); PG8_STAGE(PG8_SA(0, 1), cA + hstep, voffA);
        if (wr == 1) PG8_BAR;
        PG8_WAIT_V(4); PG8_BAR;
        PG8_STAGE(PG8_SB(1, 0), cB + kstep, voffB); PG8_STAGE(PG8_SA(1, 0), cA + kstep, voffA); PG8_STAGE(PG8_SB(1, 1), cB + hstep + kstep, voffB);
        PG8_WAIT_V(6); PG8_BAR;
    }
    for (;;) {
        const bool has_next = S.next(ui + 1, nxt);
        const char* nA = has_next ? (const char*)g.A + (size_t)nxt.pm * tstep + (size_t)nxt.kofs * 2 : cA; const char* nB = has_next ? (const char*)g.Bt + (size_t)nxt.pn * tstep + (size_t)nxt.kofs * 2 : cB;
        for (int t = 0; t < nt; t += 2) {
            const bool last = (t == nt - 2);
            const char* a1 = cA + (size_t)(t + 1) * kstep;
            const char* a2 = last ? nA : cA + (size_t)(t + 2) * kstep; const char* b2 = last ? nB : cB + (size_t)(t + 2) * kstep;
            const char* a3 = a2 + kstep; const char* b3 = b2 + kstep;
            if (last && has_next) S.a_ready(nxt);
            if constexpr (Epi::MID) { if (2 * t == nt) E.mid(acc, cur, wr, wc, fr, fq); }
            if constexpr (SP2) {
            PG8_LDB(B0, 0, 0); PG8_LDB(B1, 0, 1); PG8_SCHED; PG8_LDA(At, 0, 0); PG8_STAGE(PG8_SA(1, 1), a1 + hstep, voffA);
            PG8_WAIT_V(8); PG8_WAIT_L(0); PG8_BAR; PG8_MMA(0, 0, At, B0); PG8_MMA(0, 1, At, B1); PG8_BAR; PG8_SCHED;
            PG8_LDA(At, 0, 1); PG8_STAGE(PG8_SB(0, 0), b2, voffB); PG8_STAGE(PG8_SB(0, 1), b2 + hstep, voffB); PG8_STAGE(PG8_SA(0, 0), a2, voffA);
            PG8_WAIT_V(8); PG8_WAIT_L(0); PG8_BAR; PG8_MMA(1, 0, At, B0); PG8_MMA(1, 1, At, B1); PG8_BAR; PG8_SCHED;
            PG8_LDB(B0, 1, 0); PG8_LDB(B1, 1, 1); PG8_SCHED; PG8_LDA(At, 1, 0); PG8_STAGE(PG8_SA(0, 1), a2 + hstep, voffA);
            PG8_WAIT_V(8); PG8_WAIT_L(0); PG8_BAR; PG8_MMA(0, 0, At, B0); PG8_MMA(0, 1, At, B1); PG8_BAR; PG8_SCHED;
            PG8_LDA(At, 1, 1); PG8_STAGE(PG8_SB(1, 0), b3, voffB); PG8_STAGE(PG8_SB(1, 1), b3 + hstep, voffB); PG8_STAGE(PG8_SA(1, 0), a3, voffA);
            PG8_WAIT_V(8); PG8_WAIT_L(0); PG8_BAR; PG8_MMA(1, 0, At, B0); PG8_MMA(1, 1, At, B1); PG8_BAR; PG8_SCHED;
            } else {
            PG8_LDB(B0, 0, 0); PG8_SCHED; PG8_LDA(At, 0, 0); PG8_STAGE(PG8_SA(1, 1), a1 + hstep, voffA);
            PG8_WAIT_L(8); PG8_BAR; PG8_WAIT_L(0); PG8_MMA(0, 0, At, B0); PG8_BAR; PG8_SCHED;
            PG8_LDB(B1, 0, 1); PG8_STAGE(PG8_SB(0, 0), b2, voffB);
            PG8_BAR; PG8_WAIT_L(0); PG8_MMA(0, 1, At, B1); PG8_BAR;
            PG8_LDA(At, 0, 1); PG8_STAGE(PG8_SA(0, 0), a2, voffA);
            PG8_BAR; PG8_WAIT_L(0); PG8_MMA(1, 0, At, B0); PG8_BAR; PG8_SCHED;
            PG8_STAGE(PG8_SB(0, 1), b2 + hstep, voffB);
            PG8_WAIT_V(6); PG8_BAR; PG8_MMA(1, 1, At, B1); PG8_BAR;
            PG8_LDB(B0, 1, 0); PG8_SCHED; PG8_LDA(At, 1, 0); PG8_STAGE(PG8_SA(0, 1), a2 + hstep, voffA);
            PG8_WAIT_L(8); PG8_BAR; PG8_WAIT_L(0); PG8_MMA(0, 0, At, B0); PG8_BAR; PG8_SCHED;
            PG8_LDB(B1, 1, 1); PG8_STAGE(PG8_SB(1, 0), b3, voffB);
            PG8_BAR; PG8_WAIT_L(0); PG8_MMA(0, 1, At, B1); PG8_BAR;
            PG8_LDA(At, 1, 1); PG8_STAGE(PG8_SA(1, 0), a3, voffA);
            PG8_BAR; PG8_WAIT_L(0); PG8_MMA(1, 0, At, B0); PG8_BAR; PG8_SCHED;
            PG8_STAGE(PG8_SB(1, 1), b3 + hstep, voffB);
            PG8_WAIT_V(6); PG8_BAR; PG8_MMA(1, 1, At, B1); PG8_BAR;
            }
        }
        if constexpr (ALIGN_EPI) { if (wr == 0) PG8_BAR; }
        if constexpr (!Epi::AFTER_DRAIN) { E(acc, cur, wr, wc, fr, fq); S.done(cur); }
        if (!has_next) break;
#pragma unroll
        for (int a = 0; a < 2; ++a)
#pragma unroll
            for (int b = 0; b < 2; ++b)
#pragma unroll
                for (int m = 0; m < 4; ++m)
#pragma unroll
                    for (int n = 0; n < 2; ++n) acc[a][b][m][n] = (f32x4){0.f, 0.f, 0.f, 0.f};
        cur = nxt; cA = nA; cB = nB; ++ui;
        if constexpr (ALIGN_EPI) { if (wr == 1) PG8_BAR; }
    }
    PG8_WAIT_V(0);
    if constexpr (!ALIGN_EPI) { if (wr == 0) PG8_BAR; }
    PG8_BAR;
    if constexpr (Epi::AFTER_DRAIN) { E.fused(acc, cur, wr, wc, fr, fq, lds, wid, lane); S.done(cur); }
#undef PG8_SA
#undef PG8_SB
#undef PG8_STAGE
#undef PG8_LDA
#undef PG8_LDB
#undef PG8_MMA
#undef PG8_WAIT_V
#undef PG8_WAIT_L
#undef PG8_BAR
#undef PG8_SCHED
}
}

#define DI __device__ __forceinline__
#define LAS __attribute__((address_space(3)))
typedef unsigned short bf16_t;
typedef short bf16x8 __attribute__((ext_vector_type(8)));
typedef float f32x4 __attribute__((ext_vector_type(4)));
typedef float f32x2 __attribute__((ext_vector_type(2)));
typedef float f32x16 __attribute__((ext_vector_type(16)));
typedef unsigned u32x4 __attribute__((ext_vector_type(4)));
typedef unsigned u32x2 __attribute__((ext_vector_type(2)));
typedef __bf16 bf16x2_t __attribute__((ext_vector_type(2)));
#define MFMA32(a, b, c) __builtin_amdgcn_mfma_f32_32x32x16_bf16((a), (b), (c), 0, 0, 0)

constexpr int D = 1024, TP = 8192, MP = 65536, MS = 512, M = MP + MS, NSEQ = 24;
constexpr int RPROJ = 1792, INPROJ = 5376, DFF = 4096;
constexpr int NTHREADS = 512, NWAVES = 8;
constexpr int LDS_BYTES = 147456;
constexpr float L2E = 1.4426950408889634f;

constexpr size_t OUT_PWKV = 67633152, OUT_PSHIFT = 67895296, OUT_PK = 67909632, OUT_PV = 70006784,
                 OUT_SWKV = 72103936, OUT_SSHIFT = 72628224, OUT_SK = 72656896, OUT_SV = 72919040;

constexpr size_t al256(size_t x) { return (x + 255) & ~(size_t)255; }
constexpr size_t WS_WIN = 0;
constexpr size_t WS_WBRR = WS_WIN + (size_t)INPROJ * D * 2;
constexpr size_t WS_WBRA = WS_WBRR + (size_t)D * 512 * 2;
constexpr size_t WS_WOUT = WS_WBRA + (size_t)D * 512 * 2;
constexpr size_t WS_W1 = WS_WOUT + (size_t)D * D * 2;
constexpr size_t WS_W2 = WS_W1 + (size_t)DFF * D * 2;
constexpr size_t WS_WUP = WS_W2 + (size_t)DFF * D * 2;
constexpr size_t WS_AUP = WS_WUP + 512 * 64 * 2;
constexpr size_t WS_GUP = WS_AUP + 512 * 64 * 2;
constexpr size_t WS_MOD = WS_GUP + 512 * 128 * 2;
constexpr size_t WS_RK = al256(WS_MOD + (size_t)NSEQ * 6144 * 4);
constexpr size_t WS_KS = al256(WS_RK + (size_t)M * 8 * 4);
constexpr size_t WS_VTS = WS_KS + (size_t)16 * 576 * 512 * 2;
constexpr size_t WS_ACTA = WS_VTS + (size_t)16 * 576 * 512 * 2;
constexpr size_t WS_PR = WS_ACTA + (size_t)M * D * 2;
constexpr size_t WS_QB = WS_PR + (size_t)M * RPROJ * 2;
constexpr size_t WS_KB = WS_QB + (size_t)M * 512 * 2;
constexpr size_t WS_VT = WS_KB + (size_t)M * 512 * 2;
constexpr size_t WS_GATES = WS_VT + (size_t)M * 512 * 2;
constexpr size_t WS_YR = WS_GATES + (size_t)M * 2048 * 2;
constexpr size_t WS_YA = WS_YR + (size_t)M * 512 * 2;
constexpr size_t WS_BAR = WS_YA + (size_t)M * 512 * 2;
constexpr size_t WS_BAR_BYTES = 16384;
constexpr size_t WS_PART1 = WS_BAR + WS_BAR_BYTES;
constexpr size_t WS_PART2 = WS_PART1 + (size_t)4 * MS * D * 4;
constexpr size_t WS_END = WS_PART2 + (size_t)8 * MS * D * 4;
static_assert(WS_END <= ((size_t)1 << 30), "workspace map must fit 1 GiB");
static_assert((size_t)M * DFF * 2 <= WS_YR - WS_PR, "f overlay");
constexpr size_t WS_PBUF = WS_ACTA;
constexpr size_t WS_UBUF = WS_PBUF + (size_t)64 * 32 * 4096 * 4;
constexpr size_t WS_SST = WS_UBUF + (size_t)64 * 32 * 4096 * 4;
static_assert(WS_SST + (size_t)64 * 33 * 4096 * 4 <= WS_PR, "PU overlay");

struct Params { const float* in[31]; float* out; unsigned char* ws; };

DI float bf2f(bf16_t v) { return __builtin_bit_cast(float, (unsigned)v << 16); }
DI unsigned pk2(float lo, float hi) { f32x2 v = {lo, hi}; bf16x2_t b = __builtin_convertvector(v, bf16x2_t); return __builtin_bit_cast(unsigned, b); }
DI bf16_t f2bf(float f) { return (bf16_t)(pk2(f, 0.f) & 0xffffu); }
DI float lo_bf(unsigned u) { return __builtin_bit_cast(float, u << 16); }
DI float hi_bf(unsigned u) { return __builtin_bit_cast(float, u & 0xffff0000u); }
DI float sigmoidf_(float x) { return __builtin_amdgcn_rcpf(1.0f + __builtin_amdgcn_exp2f(-x * L2E)); }
#define DPP_ADD(v, ctrl) ((v) + __builtin_bit_cast(float, __builtin_amdgcn_update_dpp(0, __builtin_bit_cast(int, (v)), (ctrl), 0xf, 0xf, true)))
DI float wave_sum(float v) {
    v = DPP_ADD(v, 0xB1);
    v = DPP_ADD(v, 0x4E);
    v = DPP_ADD(v, 0x141);
    v = DPP_ADD(v, 0x140);
    const int iv = __builtin_bit_cast(int, v);
    const float a = __builtin_bit_cast(float, __builtin_amdgcn_readlane(iv, 0)), b = __builtin_bit_cast(float, __builtin_amdgcn_readlane(iv, 16));
    const float c = __builtin_bit_cast(float, __builtin_amdgcn_readlane(iv, 32)), d = __builtin_bit_cast(float, __builtin_amdgcn_readlane(iv, 48));
    return (a + b) + (c + d);
}
DI int opaque(int v) { asm volatile("" : "+v"(v)); return v; }
DI int lane_now() { int l; asm volatile("v_mbcnt_lo_u32_b32 %0, -1, 0\n\tv_mbcnt_hi_u32_b32 %0, -1, %0" : "=v"(l)); return l; }
DI int seq_of_row(int row) { return row < MP ? (row >> 13) : 8 + ((row - MP) >> 5); }
DI const float* xrow_ptr(const Params& p, int row) { return row < MP ? p.in[0] + (size_t)row * D : p.in[1] + (size_t)(row - MP) * D; }

#define XB_TMO      128
#define XB_XCNT(j)  (256  + 64 * (j))
#define XB_XSUB(j)  (1280 + 64 * (j))
#define XB_XGEN(j)  (2304 + 64 * (j))
#define XB_TOP      3328
#define XB_TOPGEN   3392
#define XCD_BAR_WORDS 3456
#define XB_SPIN_CAP (1u << 22)

__device__ __forceinline__ unsigned xb_ld(unsigned* p)              { return __hip_atomic_load(p, __ATOMIC_RELAXED, __HIP_MEMORY_SCOPE_AGENT); }
__device__ __forceinline__ unsigned xb_add(unsigned* p, unsigned v) { return __hip_atomic_fetch_add(p, v, __ATOMIC_RELAXED, __HIP_MEMORY_SCOPE_AGENT); }
__device__ __forceinline__ unsigned xb_xcc_id() { return (unsigned)__builtin_amdgcn_s_getreg((3 << 11) | 20) & 0xFu; }
#define XB_SPIN(cond, bar) do { unsigned _sp = 0; while (cond) { __builtin_amdgcn_s_sleep(1); \
    if ((++_sp & 255u) == 0u) { if (xb_ld(&(bar)[XB_TMO])) break; if (_sp > XB_SPIN_CAP) { atomicAdd(&(bar)[XB_TMO], 1u); break; } } } } while (0)

struct XcdBarrier {
    int w0;
    unsigned* bar; unsigned x;
    volatile LAS unsigned* st;
};

__device__ __forceinline__ XcdBarrier xcd_barrier_post(unsigned* bar, volatile LAS unsigned* st) {
    XcdBarrier b; b.bar = bar; b.x = xb_xcc_id(); b.st = st;
    if (threadIdx.x == 0) (void)xb_add(&bar[XB_XCNT(b.x)], 1u);
    return b;
}
__device__ __forceinline__ void xcd_barrier_complete(unsigned* bar, unsigned x, unsigned& nloc, unsigned& nx) {
    const unsigned G = gridDim.x * gridDim.y * gridDim.z;
    unsigned sum, cnt, mine, sp = 0u;
    for (;;) {
        sum = 0u; cnt = 0u; mine = 0u;
#pragma unroll
        for (unsigned j = 0; j < 16; ++j) { const unsigned c = xb_ld(&bar[XB_XCNT(j)]); sum += c; cnt += (c > 0u) ? 1u : 0u; mine = (j == x) ? c : mine; }
        if (sum == G) break;
        __builtin_amdgcn_s_sleep(1);
        if ((++sp & 255u) == 0u) { if (xb_ld(&bar[XB_TMO])) break; if (sp > XB_SPIN_CAP) { atomicAdd(&bar[XB_TMO], 1u); break; } }
    }
    nloc = mine > 0u ? mine : 1u; nx = cnt > 0u ? cnt : 1u;
}

__device__ __forceinline__ void xcd_barrier(const XcdBarrier& b) {
    asm volatile("s_waitcnt vmcnt(0)" ::: "memory");
    __syncthreads();
    if (b.w0 == 0 && lane_now() == 0) {
        unsigned* bar = b.bar;
        __builtin_amdgcn_s_waitcnt(0);
        unsigned nloc = b.st[0], nx = b.st[1];
        if (nloc == 0u) { xcd_barrier_complete(bar, b.x, nloc, nx); b.st[0] = nloc; b.st[1] = nx; }
        const unsigned old = xb_add(&bar[XB_XSUB(b.x)], 1u);
        const unsigned gen = old / nloc;
        if (old + 1u == (gen + 1u) * nloc) {
            __builtin_amdgcn_fence(__ATOMIC_RELEASE, "agent");
            asm volatile("s_waitcnt vmcnt(0)" ::: "memory");
            const unsigned og = xb_add(&bar[XB_TOP], 1u);
            const unsigned tg = og / nx;
            if (og + 1u == (tg + 1u) * nx) xb_add(&bar[XB_TOPGEN], 1u);
            else XB_SPIN(xb_ld(&bar[XB_TOPGEN]) == tg, bar);
            __builtin_amdgcn_fence(__ATOMIC_ACQUIRE, "agent");
            xb_add(&bar[XB_XGEN(b.x)], 1u);
            asm volatile("s_waitcnt vmcnt(0)" ::: "memory");
        } else {
            XB_SPIN(xb_ld(&bar[XB_XGEN(b.x)]) == gen, bar);
            __builtin_amdgcn_fence(__ATOMIC_ACQUIRE, "agent");
            asm volatile("s_waitcnt vmcnt(0)" ::: "memory");
        }
    }
    __syncthreads();
}


#define EPI_LOOP_BEGIN \
    _Pragma("unroll") for (int ai = 0; ai < 2; ++ai) _Pragma("unroll") for (int m = 0; m < 4; ++m) { \
        const int row = u.pm * 256 + ai * 128 + wr * 64 + m * 16 + fr; \
        _Pragma("unroll") for (int bj = 0; bj < 2; ++bj) { \
            const int col0 = u.pn * 256 + bj * 128 + wc * 32 + 8 * fq; \
            const f32x4 v0 = acc[ai][bj][m][0], v1 = acc[ai][bj][m][1];
#define EPI_LOOP_END } }

DI u32x4 pack8(f32x4 a, f32x4 b) { u32x4 w; w.x = pk2(a[0], a[1]); w.y = pk2(a[2], a[3]); w.z = pk2(b[0], b[1]); w.w = pk2(b[2], b[3]); return w; }

struct EpiProj {
    static constexpr bool PERM = true, AFTER_DRAIN = false, MID = false;
    bf16_t *pr, *qb, *kb, *vt, *gates, *ks, *vts; float* out;
    DI void operator()(const f32x4 (&acc)[2][2][4][2], const pg8::Unit& u, int wr, int wc, int fr, int fq) const {
        const int pn = u.pn;
        if (pn < 7) {
            EPI_LOOP_BEGIN
                *(u32x4*)(pr + (size_t)row * RPROJ + col0) = pack8(v0, v1);
                float* so = nullptr;
                if (row < MP) { if ((row & 8191) == 8191) so = out + OUT_PSHIFT + (size_t)(row >> 13) * RPROJ + col0; }
                else { if (((row - MP) & 31) == 31) so = out + OUT_SSHIFT + (size_t)((row - MP) >> 5) * RPROJ + col0; }
                if (so) { *(f32x4*)so = v0; *(f32x4*)(so + 4) = v1; }
            EPI_LOOP_END
        } else if (pn < 9) {
            EPI_LOOP_BEGIN
                const int c = col0 - 1792, hh = c >> 6, d = c & 63;
                size_t qi;
                if (row < MP) qi = ((size_t)((row >> 13) * 8 + hh) * 8192 + (row & 8191)) * 64 + d;
                else { const int sr = row - MP; qi = (size_t)MP * 512 + ((size_t)((sr >> 5) * 8 + hh) * 32 + (sr & 31)) * 64 + d; }
                *(u32x4*)(qb + qi) = pack8(v0 * (0.125f * L2E), v1 * (0.125f * L2E));
            EPI_LOOP_END
        } else if (pn < 11) {
            EPI_LOOP_BEGIN
                const int c = col0 - 2304, hh = c >> 6, d = c & 63;
                const u32x4 w = pack8(v0, v1);
                float* so = nullptr;
                if (row < MP) { const int t = row & 8191, b = row >> 13; if (t >= 7680) so = out + OUT_PK + ((size_t)b * 512 + (t - 7680)) * 512 + c;
                                *(u32x4*)(kb + ((size_t)(b * 8 + hh) * 8192 + t) * 64 + d) = w; }
                else { const int sr = row - MP; so = out + OUT_SK + (size_t)sr * 512 + c;
                       *(u32x4*)(ks + ((size_t)((sr >> 5) * 8 + hh) * 576 + 512 + (sr & 31)) * 64 + d) = w; }
                if (so) { *(f32x4*)so = v0; *(f32x4*)(so + 4) = v1; }
            EPI_LOOP_END
        } else if (pn < 13) {
            EPI_LOOP_BEGIN
                const int c = col0 - 2816, hh = c >> 6, d = c & 63;
                float* so = nullptr; bf16_t* tp; const size_t pitch = 32;
                if (row < MP) { const int t = row & 8191, b = row >> 13; if (t >= 7680) so = out + OUT_PV + ((size_t)b * 512 + (t - 7680)) * 512 + c;
                                tp = vt + (((size_t)(b * 8 + hh) * 256 + (t >> 5)) * 64 + d) * 32 + (t & 31); }
                else { const int sr = row - MP; so = out + OUT_SV + (size_t)sr * 512 + c;
                       tp = vts + (((size_t)((sr >> 5) * 8 + hh) * 18 + 16) * 64 + d) * 32 + (sr & 31); }
                if (so) { *(f32x4*)so = v0; *(f32x4*)(so + 4) = v1; }
                tp[0] = f2bf(v0[0]); tp[pitch] = f2bf(v0[1]); tp[2 * pitch] = f2bf(v0[2]); tp[3 * pitch] = f2bf(v0[3]);
                tp[4 * pitch] = f2bf(v1[0]); tp[5 * pitch] = f2bf(v1[1]); tp[6 * pitch] = f2bf(v1[2]); tp[7 * pitch] = f2bf(v1[3]);
            EPI_LOOP_END
        } else {
            EPI_LOOP_BEGIN
                f32x4 s0, s1;
#pragma unroll
                for (int i = 0; i < 4; ++i) { s0[i] = sigmoidf_(v0[i]); s1[i] = sigmoidf_(v1[i]); }
                *(u32x4*)(gates + (size_t)row * 2048 + (col0 - 3328)) = pack8(s0, s1);
            EPI_LOOP_END
        }
    }
};

DI void unpack8(u32x4 w, f32x4& a, f32x4& b) { a[0] = lo_bf(w.x); a[1] = hi_bf(w.x); a[2] = lo_bf(w.y); a[3] = hi_bf(w.y); b[0] = lo_bf(w.z); b[1] = hi_bf(w.z); b[2] = lo_bf(w.w); b[3] = hi_bf(w.w); }

struct EpiMerge {
    static constexpr bool PERM = true, AFTER_DRAIN = false, MID = true;
    const bf16_t* gates; bf16_t* O;
    DI void mid(f32x4 (&acc)[2][2][4][2], const pg8::Unit& u, int wr, int wc, int fr, int fq) const {
#pragma unroll
        for (int ai = 0; ai < 2; ++ai)
#pragma unroll
            for (int m = 0; m < 4; ++m) {
                const int row = u.pm * 256 + ai * 128 + wr * 64 + m * 16 + fr;
#pragma unroll
                for (int bj = 0; bj < 2; ++bj) {
                    const int col0 = u.pn * 256 + bj * 128 + wc * 32 + 8 * fq;
                    f32x4 r0, r1, a0, a1;
                    unpack8(*(const u32x4*)(gates + (size_t)row * 2048 + col0), r0, r1);
                    unpack8(*(const u32x4*)(gates + (size_t)row * 2048 + 1024 + col0), a0, a1);
#pragma unroll
                    for (int i = 0; i < 4; ++i) { acc[ai][bj][m][0][i] *= r0[i] * __builtin_amdgcn_rcpf(fmaxf(a0[i], 1e-30f)); acc[ai][bj][m][1][i] *= r1[i] * __builtin_amdgcn_rcpf(fmaxf(a1[i], 1e-30f)); }
                }
            }
    }
    DI void operator()(const f32x4 (&acc)[2][2][4][2], const pg8::Unit& u, int wr, int wc, int fr, int fq) const {
        EPI_LOOP_BEGIN
            f32x4 a0, a1; unpack8(*(const u32x4*)(gates + (size_t)row * 2048 + 1024 + col0), a0, a1);
            *(u32x4*)(O + (size_t)row * D + col0) = pack8(v0 * a0, v1 * a1);
        EPI_LOOP_END
    }
};
struct EpiRes {
    static constexpr bool PERM = true, AFTER_DRAIN = false, MID = false;
    const float* xp; const float* xs; const float* mod; int moff; float* dst;
    DI void operator()(const f32x4 (&acc)[2][2][4][2], const pg8::Unit& u, int wr, int wc, int fr, int fq) const {
        EPI_LOOP_BEGIN
            const float* src = (row < MP ? xp + (size_t)row * D : xs + (size_t)(row - MP) * D) + col0;
            const float* mg = mod + (size_t)seq_of_row(row) * 6144 + moff + col0;
            const f32x4 x0 = *(const f32x4*)src, x1 = *(const f32x4*)(src + 4), m0 = *(const f32x4*)mg, m1 = *(const f32x4*)(mg + 4);
            float* dp = dst + (size_t)row * D + col0;
            *(f32x4*)dp = x0 + m0 * v0; *(f32x4*)(dp + 4) = x1 + m1 * v1;
        EPI_LOOP_END
    }
};
struct EpiResB16 {
    static constexpr bool PERM = true, AFTER_DRAIN = false, MID = false;
    const float* xp; const float* mod; int moff; bf16_t* xb; bool inplace;
    DI void operator()(const f32x4 (&acc)[2][2][4][2], const pg8::Unit& u, int wr, int wc, int fr, int fq) const {
        EPI_LOOP_BEGIN
            const float* mg = mod + (size_t)(row >> 13) * 6144 + moff + col0;
            const f32x4 m0 = *(const f32x4*)mg, m1 = *(const f32x4*)(mg + 4);
            bf16_t* dp = xb + (size_t)row * D + col0;
            f32x4 x0, x1;
            if (inplace) unpack8(*(const u32x4*)dp, x0, x1);
            else { const float* src = xp + (size_t)row * D + col0; x0 = *(const f32x4*)src; x1 = *(const f32x4*)(src + 4); }
            *(u32x4*)dp = pack8(x0 + m0 * v0, x1 + m1 * v1);
        EPI_LOOP_END
    }
};
struct EpiResPart {
    static constexpr bool PERM = true, AFTER_DRAIN = false, MID = false;
    const float* mod; int moff; float* part; int kslice;
    DI void operator()(const f32x4 (&acc)[2][2][4][2], const pg8::Unit& u, int wr, int wc, int fr, int fq) const {
        float* pb = part + (size_t)(u.kofs / kslice) * MS * D;
        EPI_LOOP_BEGIN
            const float* mg = mod + (size_t)seq_of_row(row) * 6144 + moff + col0;
            const f32x4 m0 = *(const f32x4*)mg, m1 = *(const f32x4*)(mg + 4);
            float* dp = pb + (size_t)(row - MP) * D + col0;
            *(f32x4*)dp = m0 * v0; *(f32x4*)(dp + 4) = m1 * v1;
        EPI_LOOP_END
    }
};
struct RevRowOrder : pg8::StaticOrder {
    DI bool next(int i, pg8::Unit& u) const { if (!pg8::StaticOrder::next(i, u)) return false; u.pm = nM - 1 - u.pm; return true; }
};
struct SliceOrder {
    int G, c, nslice, kslice, npn;
    DI bool next(int i, pg8::Unit& u) const {
        const int L = i * G + c, per = 2 * npn; if (L >= nslice * per) return false;
        const int ks = L / per, rem = L - ks * per; u.pm = MP / 256 + rem / npn; u.pn = rem % npn; u.kofs = ks * kslice; return true;
    }
    DI void a_ready(const pg8::Unit&) const {}
    DI void done(const pg8::Unit&) const {}
};
struct EpiSqrelu {
    static constexpr bool PERM = true, AFTER_DRAIN = false, MID = false;
    bf16_t* F;
    DI void operator()(const f32x4 (&acc)[2][2][4][2], const pg8::Unit& u, int wr, int wc, int fr, int fq) const {
        EPI_LOOP_BEGIN
            f32x4 a, b;
#pragma unroll
            for (int i = 0; i < 4; ++i) { const float p0 = fmaxf(v0[i], 0.f), p1 = fmaxf(v1[i], 0.f); a[i] = p0 * p0; b[i] = p1 * p1; }
            *(u32x4*)(F + (size_t)row * DFF + col0) = pack8(a, b);
        EPI_LOOP_END
    }
};

DI void transpose_item(const float* W, int N, bf16_t* WT, int opitch, int item, LAS float* scr, int tid) {
    const int ntn = N >> 6, kt = item / ntn, nt = item - kt * ntn;
    __syncthreads();
#pragma unroll
    for (int i = 0; i < 8; ++i) { const int e = tid + i * NTHREADS, r = e >> 6, c = e & 63; scr[r * 65 + c] = W[(size_t)(kt * 64 + r) * N + nt * 64 + c]; }
    __syncthreads();
#pragma unroll
    for (int i = 0; i < 8; ++i) { const int e = tid + i * NTHREADS, r = e >> 6, c = e & 63; WT[(size_t)(nt * 64 + r) * opitch + kt * 64 + c] = f2bf(scr[c * 65 + r]); }
}

DI void phase0(const Params& p, LAS unsigned char* lds, int tid, int bid, int nb) {
    unsigned char* ws = p.ws;
    LAS float* scr = (LAS float*)lds;
    int base = 0;
#define TRJOB2(Wp, Kd, Nd, off, opitch) do { const int nit = ((Kd) >> 6) * ((Nd) >> 6); const int first = (bid - (base % nb) + nb) % nb; \
        _Pragma("unroll 1") for (int it = first; it < nit; it += nb) transpose_item((Wp), (Nd), (bf16_t*)(ws + (off)), (opitch), it, scr, tid); base += nit; } while (0)
#define TRJOB(Wp, Kd, Nd, off) do { const int nit = ((Kd) >> 6) * ((Nd) >> 6); const int first = (bid - (base % nb) + nb) % nb; \
        _Pragma("unroll 1") for (int it = first; it < nit; it += nb) transpose_item((Wp), (Nd), (bf16_t*)(ws + (off)), (Kd), it, scr, tid); base += nit; } while (0)
    TRJOB(p.in[11], D, INPROJ, WS_WIN); TRJOB2(p.in[24], 512, D, WS_WBRR, D); TRJOB2(p.in[25], 512, D, WS_WBRR + 1024, D);
    TRJOB(p.in[26], D, D, WS_WOUT); TRJOB(p.in[28], D, DFF, WS_W1); TRJOB(p.in[29], DFF, D, WS_W2);
    TRJOB(p.in[13], 64, 512, WS_WUP); TRJOB(p.in[15], 64, 512, WS_AUP); TRJOB(p.in[17], 128, 512, WS_GUP);
#undef TRJOB
#undef TRJOB2
    {
        bf16_t* ks = (bf16_t*)(ws + WS_KS); bf16_t* vts = (bf16_t*)(ws + WS_VTS);
        const float* ck = p.in[6]; const float* cv = p.in[7];
        for (int e = bid * NTHREADS + tid; e < 16 * 512 * 128; e += nb * NTHREADS) {
            const int s_ = e >> 16, rem = e & 65535, j = rem >> 7, c4 = (rem & 127) * 4, hh = c4 >> 6, d = c4 & 63;
            const f32x4 v = *(const f32x4*)(ck + (size_t)s_ * 262144 + (size_t)rem * 4);
            u32x2 w; w.x = pk2(v[0], v[1]); w.y = pk2(v[2], v[3]);
            *(u32x2*)(ks + ((size_t)(s_ * 8 + hh) * 576 + j) * 64 + d) = w;
        }
#pragma unroll 1
        for (int it = bid; it < 16 * 8 * 8; it += nb) {
            const int sh = it >> 3, jt2 = it & 7, s_ = sh >> 3, hh = sh & 7;
            __syncthreads();
#pragma unroll
            for (int i = 0; i < 8; ++i) { const int e = tid + i * NTHREADS, j = e >> 6, d = e & 63; scr[j * 65 + d] = cv[(size_t)s_ * 262144 + (size_t)(jt2 * 64 + j) * 512 + hh * 64 + d]; }
            __syncthreads();
#pragma unroll
            for (int i = 0; i < 8; ++i) { const int e = tid + i * NTHREADS, half = e >> 11, d = (e >> 5) & 63, jj = e & 31;
                vts[(((size_t)sh * 18 + jt2 * 2 + half) * 64 + d) * 32 + jj] = f2bf(scr[(half * 32 + jj) * 65 + d]); }
        }
    }
    {
        __syncthreads();
        LAS float* sc = (LAS float*)lds;
        LAS float* part = (LAS float*)(lds + 98304);
        bool have = false;
#pragma unroll 1
        for (int un = bid; un < 192; un += nb) {
            if (!have) {
                for (int e = tid; e < NSEQ * D; e += NTHREADS) { const int s = e >> 10, k = e & 1023; const float c = s < 8 ? p.in[2][s * D + k] : p.in[3][(s - 8) * D + k]; sc[e] = c * sigmoidf_(c); }
                have = true;
            }
            __syncthreads();
            const int kg = tid >> 5, col = tid & 31, c0 = un * 32;
            float acc[NSEQ];
#pragma unroll
            for (int s = 0; s < NSEQ; ++s) acc[s] = 0.f;
            const float* wp = p.in[8] + (size_t)(kg * 64) * 6144 + c0 + col;
#pragma unroll 4
            for (int k = 0; k < 64; ++k) {
                const float w = wp[(size_t)k * 6144];
#pragma unroll
                for (int s = 0; s < NSEQ; ++s) acc[s] += sc[s * D + kg * 64 + k] * w;
            }
#pragma unroll
            for (int s = 0; s < NSEQ; ++s) { acc[s] += __shfl_xor(acc[s], 32); }
            const int wv = tid >> 6;
            if ((tid & 32) == 0) {
#pragma unroll
                for (int s = 0; s < NSEQ; ++s) part[(wv * NSEQ + s) * 32 + col] = acc[s];
            }
            __syncthreads();
            float* mod = (float*)(ws + WS_MOD);
            for (int e = tid; e < NSEQ * 32; e += NTHREADS) {
                const int s = e >> 5, c = e & 31; float v = p.in[9][c0 + c];
#pragma unroll
                for (int w8 = 0; w8 < 8; ++w8) v += part[(w8 * NSEQ + s) * 32 + c];
                mod[(size_t)s * 6144 + c0 + c] = v;
            }
        }
    }
}

DI void load_b16_row(const bf16_t* rp, int lane, f32x4 (&v)[4]) {
#pragma unroll
    for (int i = 0; i < 4; ++i) { const u32x2 w = *(const u32x2*)(rp + i * 256 + lane * 4); v[i] = (f32x4){lo_bf(w.x), hi_bf(w.x), lo_bf(w.y), hi_bf(w.y)}; }
}
template <int MODE>
DI void norm_phase(const Params& p, bf16_t* xb, const float* part, int npart, const float* g, int sh_off, int sc_off, bf16_t* dst, int gw, int nw, int lane) {
    const float* mod = (const float*)(p.ws + WS_MOD);
    constexpr int NR = 4;
#pragma unroll 1
    for (int row0 = gw; row0 < M; row0 += NR * nw) {
        f32x4 v[NR][4];
#pragma unroll
        for (int q = 0; q < NR; ++q) {
            const int row = min(row0 + q * nw, M - 1);
            if (MODE == 0 || (MODE == 1 && row >= MP)) {
                const float* xr = xrow_ptr(p, row);
#pragma unroll
                for (int i = 0; i < 4; ++i) v[q][i] = *(const f32x4*)(xr + i * 256 + lane * 4);
            } else load_b16_row(xb + (size_t)row * D, lane, v[q]);
        }
#pragma unroll
        for (int q = 0; q < NR; ++q) {
            const int row = row0 + q * nw;
            if (row >= M) break;
            if (MODE != 0 && row >= MP) {
#pragma unroll 1
                for (int s_ = 0; s_ < npart; ++s_)
#pragma unroll
                    for (int i = 0; i < 4; ++i) v[q][i] += *(const f32x4*)(part + ((size_t)s_ * MS + (row - MP)) * D + i * 256 + lane * 4);
                if (MODE == 1) {
#pragma unroll
                    for (int i = 0; i < 4; ++i) { u32x2 w; w.x = pk2(v[q][i][0], v[q][i][1]); w.y = pk2(v[q][i][2], v[q][i][3]); *(u32x2*)(xb + (size_t)row * D + i * 256 + lane * 4) = w; }
                }
            }
            float ss = 0.f;
#pragma unroll
            for (int i = 0; i < 4; ++i) ss += v[q][i][0] * v[q][i][0] + v[q][i][1] * v[q][i][1] + v[q][i][2] * v[q][i][2] + v[q][i][3] * v[q][i][3];
            ss = wave_sum(ss);
            const float rstd = __builtin_amdgcn_rsqf(ss * (1.0f / D) + 1e-6f);
            if (MODE == 2) {
                float* yr = p.out + (size_t)row * D;
#pragma unroll
                for (int i = 0; i < 4; ++i) { const int c = i * 256 + lane * 4; *(f32x4*)(yr + c) = (v[q][i] * rstd) * *(const f32x4*)(g + c); }
            } else {
                const float* mr = mod + (size_t)seq_of_row(row) * 6144;
#pragma unroll
                for (int i = 0; i < 4; ++i) {
                    const int c = i * 256 + lane * 4;
                    const f32x4 gg = *(const f32x4*)(g + c), sh = *(const f32x4*)(mr + sh_off + c), sc = *(const f32x4*)(mr + sc_off + c);
                    const f32x4 y = (v[q][i] * rstd) * gg * (sc + 1.0f) + sh;
                    u32x2 w; w.x = pk2(y[0], y[1]); w.y = pk2(y[2], y[3]);
                    *(u32x2*)(dst + (size_t)row * D + c) = w;
                }
            }
        }
    }
}

DI int crow(int r, int hi) { return (r & 3) + 8 * (r >> 2) + 4 * hi; }
DI void attn_unit(const bf16_t* Q, const bf16_t* K, const bf16_t* VT, int jh0, int jh1, int nq, bf16_t* Y, LAS const float* tab, int lane) {
    const int l32 = lane & 31, hi = lane >> 5;
    const int q0r = min(l32, nq - 1), q1r = min(32 + l32, nq - 1);
    f32x16 O[2][2];
#pragma unroll
    for (int a = 0; a < 2; ++a)
#pragma unroll
        for (int b = 0; b < 2; ++b)
#pragma unroll
            for (int i = 0; i < 16; ++i) O[a][b][i] = 0.f;
    float mrun[2] = {-1e30f, -1e30f}, lrun[2] = {0.f, 0.f};
    bf16x8 qf[2][4];
#pragma unroll
    for (int ks = 0; ks < 4; ++ks) { qf[0][ks] = *(const bf16x8*)(Q + q0r * 64 + ks * 16 + hi * 8); qf[1][ks] = *(const bf16x8*)(Q + q1r * 64 + ks * 16 + hi * 8); }
    bf16x8 kf[4];
#pragma unroll
    for (int ks = 0; ks < 4; ++ks) kf[ks] = *(const bf16x8*)(K + (ptrdiff_t)(jh0 * 32 + l32) * 64 + ks * 16 + hi * 8);
    bf16x8 vn[2][2];
#pragma unroll
    for (int db = 0; db < 2; ++db)
#pragma unroll
        for (int sub = 0; sub < 2; ++sub) {
            const bf16_t* vp = VT + (ptrdiff_t)jh0 * 2048 + (db * 32 + l32) * 32 + sub * 16 + 4 * hi;
            const u32x2 lo = *(const u32x2*)vp, hi2 = *(const u32x2*)(vp + 8);
            u32x4 w; w.x = lo.x; w.y = lo.y; w.z = hi2.x; w.w = hi2.y;
            vn[db][sub] = __builtin_bit_cast(bf16x8, w);
        }
#pragma unroll 1
    for (int jh = jh0; jh < jh1; ++jh) {
        f32x16 st[2];
#pragma unroll
        for (int i = 0; i < 16; ++i) { st[0][i] = 0.f; st[1][i] = 0.f; }
#pragma unroll
        for (int ks = 0; ks < 4; ++ks) {
            st[0] = MFMA32(kf[ks], qf[0][ks], st[0]);
            st[1] = MFMA32(kf[ks], qf[1][ks], st[1]);
        }
        {
            const int jn = min(jh + 1, jh1 - 1);
#pragma unroll
            for (int ks = 0; ks < 4; ++ks) kf[ks] = *(const bf16x8*)(K + (ptrdiff_t)(jn * 32 + l32) * 64 + ks * 16 + hi * 8);
        }
        bf16x8 vf[2][2];
#pragma unroll
        for (int db = 0; db < 2; ++db)
#pragma unroll
            for (int sub = 0; sub < 2; ++sub) vf[db][sub] = vn[db][sub];
        {
            const int jn = min(jh + 1, jh1 - 1);
#pragma unroll
            for (int db = 0; db < 2; ++db)
#pragma unroll
                for (int sub = 0; sub < 2; ++sub) {
                    const bf16_t* vp = VT + (ptrdiff_t)jn * 2048 + (db * 32 + l32) * 32 + sub * 16 + 4 * hi;
                    const u32x2 lo = *(const u32x2*)vp, hi2 = *(const u32x2*)(vp + 8);
                    u32x4 w; w.x = lo.x; w.y = lo.y; w.z = hi2.x; w.w = hi2.y;
                    vn[db][sub] = __builtin_bit_cast(bf16x8, w);
                }
        }
        bf16x8 pf[2][2];
#pragma unroll
        for (int qb = 0; qb < 2; ++qb) {
            const int qi = qb * 32 + l32;
            float mx = -1e30f;
#pragma unroll
            for (int i = 0; i < 16; ++i) {
                float sv = st[qb][i];
                if (jh >= 12) { const int dist = qi - (jh * 32 - 512 + crow(i, hi)); sv += tab[min(dist, 128) + 128]; }
                st[qb][i] = sv; mx = fmaxf(mx, sv);
            }
            mx = fmaxf(mx, __shfl_xor(mx, 32));
            const float mnew = fmaxf(mrun[qb], mx), alpha = __builtin_amdgcn_exp2f(mrun[qb] - mnew);
            mrun[qb] = mnew;
            float ps = 0.f;
#pragma unroll
            for (int i = 0; i < 16; ++i) { const float pv = __builtin_amdgcn_exp2f(st[qb][i] - mnew); st[qb][i] = pv; ps += pv; }
#pragma unroll
            for (int sub = 0; sub < 2; ++sub) {
                u32x4 w;
                w.x = pk2(st[qb][sub * 8 + 0], st[qb][sub * 8 + 1]); w.y = pk2(st[qb][sub * 8 + 2], st[qb][sub * 8 + 3]);
                w.z = pk2(st[qb][sub * 8 + 4], st[qb][sub * 8 + 5]); w.w = pk2(st[qb][sub * 8 + 6], st[qb][sub * 8 + 7]);
                pf[sub][qb] = __builtin_bit_cast(bf16x8, w);
            }
            lrun[qb] = lrun[qb] * alpha + ps;
            if (__builtin_amdgcn_ballot_w64(alpha != 1.0f) != 0ull) {
#pragma unroll
                for (int db = 0; db < 2; ++db)
#pragma unroll
                    for (int i = 0; i < 16; ++i) O[db][qb][i] *= alpha;
            }
        }
#pragma unroll
        for (int db = 0; db < 2; ++db)
#pragma unroll
            for (int sub = 0; sub < 2; ++sub) {
                O[db][0] = MFMA32(vf[db][sub], pf[sub][0], O[db][0]);
                O[db][1] = MFMA32(vf[db][sub], pf[sub][1], O[db][1]);
            }
    }
#pragma unroll
    for (int qb = 0; qb < 2; ++qb) {
        const float lt = lrun[qb] + __shfl_xor(lrun[qb], 32), inv = 1.0f / lt;
        const int q = qb * 32 + l32;
        if (q < nq) {
#pragma unroll
            for (int db = 0; db < 2; ++db)
#pragma unroll
                for (int g = 0; g < 4; ++g) {
                    u32x2 w; w.x = pk2(O[db][qb][4 * g] * inv, O[db][qb][4 * g + 1] * inv); w.y = pk2(O[db][qb][4 * g + 2] * inv, O[db][qb][4 * g + 3] * inv);
                    *(u32x2*)(Y + (size_t)q * 1024 + db * 32 + 8 * g + 4 * hi) = w;
                }
        }
    }
}

constexpr int TAB_BYTES = 8448;
constexpr int PW = 72, PG = 136;
struct PrepW { bf16x8 wf[2][4], af[2][4], gf[2][8]; };
DI void prep_load(const Params& p, PrepW& W, int wid, int lane) {
    const int l32 = lane & 31, hi = lane >> 5;
    const bf16_t* wup = (const bf16_t*)(p.ws + WS_WUP); const bf16_t* aup = (const bf16_t*)(p.ws + WS_AUP); const bf16_t* gup = (const bf16_t*)(p.ws + WS_GUP);
#pragma unroll
    for (int cb = 0; cb < 2; ++cb) {
        const int chr = wid * 64 + cb * 32 + l32;
#pragma unroll
        for (int ks = 0; ks < 4; ++ks) { W.wf[cb][ks] = *(const bf16x8*)(wup + (size_t)chr * 64 + ks * 16 + hi * 8); W.af[cb][ks] = *(const bf16x8*)(aup + (size_t)chr * 64 + ks * 16 + hi * 8); }
#pragma unroll
        for (int ks = 0; ks < 8; ++ks) W.gf[cb][ks] = *(const bf16x8*)(gup + (size_t)chr * 128 + ks * 16 + hi * 8);
    }
}
DI void prep_unit(const Params& p, const PrepW& W, int tile, LAS unsigned char* lds, int tid, int wid, int lane) {
    const bf16_t* pr = (const bf16_t*)(p.ws + WS_PR);
    LAS bf16_t* aW = (LAS bf16_t*)(lds + TAB_BYTES);
    LAS bf16_t* aA = aW + 64 * PW;
    LAS bf16_t* aG = aA + 64 * PW;
    LAS const float* lbias = (LAS const float*)(lds + TAB_BYTES + 36864);
    __syncthreads();
    {
        const int tid_o = opaque(tid);
        const int tok = tid_o >> 3, cgi = tid_o & 7, row = tile * 64 + tok, c0 = 1536 + cgi * 32;
        const bf16_t* cur = pr + (size_t)row * RPROJ + c0;
        int mode = 0;
        const float* sp = nullptr;
        if (row < MP) { if ((row & 8191) == 0) mode = 1; }
        else { const int sr = row - MP; if ((sr & 31) == 0) { mode = 2; sp = p.in[5] + (size_t)(sr >> 5) * RPROJ + c0; } }
        const float* mu = p.in[12] + c0;
#pragma unroll 2
        for (int q = 0; q < 4; ++q) {
            f32x4 c0v, c1v, p0v, p1v;
            unpack8(*(const u32x4*)(cur + q * 8), c0v, c1v);
            if (mode == 0) unpack8(*(const u32x4*)(cur - RPROJ + q * 8), p0v, p1v);
            else if (mode == 1) { p0v = (f32x4){0.f, 0.f, 0.f, 0.f}; p1v = p0v; }
            else { p0v = *(const f32x4*)(sp + q * 8); p1v = *(const f32x4*)(sp + q * 8 + 4); }
            const f32x4 m0 = *(const f32x4*)(mu + q * 8), m1 = *(const f32x4*)(mu + q * 8 + 4);
            f32x4 x0 = c0v + (p0v - c0v) * m0, x1 = c1v + (p1v - c1v) * m1;
            const int cc = cgi * 32 + q * 8;
            LAS bf16_t* dstp;
            if (cgi < 2) {
#pragma unroll
                for (int i = 0; i < 4; ++i) { x0[i] = 1.0f - 2.0f * __builtin_amdgcn_rcpf(__builtin_amdgcn_exp2f(2.0f * L2E * x0[i]) + 1.0f); x1[i] = 1.0f - 2.0f * __builtin_amdgcn_rcpf(__builtin_amdgcn_exp2f(2.0f * L2E * x1[i]) + 1.0f); }
                dstp = aW + tok * PW + cc;
            } else if (cgi < 4) { dstp = aA + tok * PW + (cc - 64); }
            else {
#pragma unroll
                for (int i = 0; i < 4; ++i) { x0[i] = sigmoidf_(x0[i]); x1[i] = sigmoidf_(x1[i]); }
                dstp = aG + tok * PG + (cc - 128);
            }
            *(LAS u32x4*)dstp = pack8(x0, x1);
        }
    }
    __syncthreads();
    const int l32 = lane & 31, hi = lane >> 5;
    bf16_t* abuf = (bf16_t*)p.out;
    bf16_t* ebuf = abuf + (size_t)M * 512;
    bf16_t* gbuf = ebuf + (size_t)M * 512;
#pragma unroll
    for (int lo = 0; lo < 3; ++lo) {
        const int Kd = lo == 2 ? 128 : 64;
        LAS const bf16_t* act = lo == 0 ? aW : lo == 1 ? aA : aG;
        const int pitch = lo == 2 ? PG : PW;
        bf16_t* obuf = lo == 0 ? ebuf : lo == 1 ? abuf : gbuf;
#pragma unroll
        for (int cb = 0; cb < 2; ++cb) {
            f32x16 acc[2];
#pragma unroll
            for (int i = 0; i < 16; ++i) { acc[0][i] = 0.f; acc[1][i] = 0.f; }
#pragma unroll
            for (int ks = 0; ks < Kd / 16; ++ks) {
                const bf16x8 af = lo == 0 ? W.wf[cb][ks & 3] : lo == 1 ? W.af[cb][ks & 3] : W.gf[cb][ks];
#pragma unroll
                for (int tb = 0; tb < 2; ++tb) {
                    const bf16x8 bfr = *(LAS const bf16x8*)(act + (tb * 32 + l32) * pitch + ks * 16 + hi * 8);
                    acc[tb] = MFMA32(af, bfr, acc[tb]);
                }
            }
#pragma unroll
            for (int tb = 0; tb < 2; ++tb) {
                const int row = tile * 64 + tb * 32 + l32;
#pragma unroll
                for (int g = 0; g < 4; ++g) {
                    const int ch = wid * 64 + cb * 32 + 8 * g + 4 * hi;
                    float o[4];
                    f32x4 bv = {0.f, 0.f, 0.f, 0.f};
                    if (lo < 2) bv = *(LAS const f32x4*)(lbias + lo * 512 + ch);
#pragma unroll
                    for (int i = 0; i < 4; ++i) {
                        float z = acc[tb][4 * g + i];
                        if (lo == 0) z = 0.6065306597f * sigmoidf_(z + bv[i]);
                        else if (lo == 1) z = sigmoidf_(z + bv[i]);
                        o[i] = z;
                    }
                    u32x2 w; w.x = pk2(o[0], o[1]); w.y = pk2(o[2], o[3]);
                    *(u32x2*)(obuf + (size_t)row * 512 + ch) = w;
                }
            }
        }
    }
}

constexpr int STG_TOK = 384;
struct ScanC { float mu_r, mu_k, mu_v, kkc, kac, rkc; };
constexpr int RAW_BYTES = 5 * 8 * 128;
DI void scan_prefetch8(const bf16_t* pr, const bf16_t* abuf, const bf16_t* ebuf, LAS unsigned char* raw, unsigned rbase, int h, int lane) {
    const unsigned tok = (unsigned)(lane >> 5), d = (unsigned)(lane & 31);
#pragma unroll
    for (int jp = 0; jp < 4; ++jp) {
        const unsigned row = rbase + 2u * jp + tok;
        const bf16_t* g0 = pr + (size_t)row * RPROJ + h * 64 + 2 * d;
        const size_t ai = (size_t)row * 512 + h * 64 + 2 * d;
        __builtin_amdgcn_global_load_lds((const unsigned*)g0, (LAS unsigned*)(raw + (0 * 4 + jp) * 256), 4, 0, 0);
        __builtin_amdgcn_global_load_lds((const unsigned*)(g0 + 512), (LAS unsigned*)(raw + (1 * 4 + jp) * 256), 4, 0, 0);
        __builtin_amdgcn_global_load_lds((const unsigned*)(g0 + 1024), (LAS unsigned*)(raw + (2 * 4 + jp) * 256), 4, 0, 0);
        __builtin_amdgcn_global_load_lds((const unsigned*)(abuf + ai), (LAS unsigned*)(raw + (3 * 4 + jp) * 256), 4, 0, 0);
        __builtin_amdgcn_global_load_lds((const unsigned*)(ebuf + ai), (LAS unsigned*)(raw + (4 * 4 + jp) * 256), 4, 0, 0);
    }
}
template <bool FROM_LDS>
DI void scan_stage8(const bf16_t* pr, const bf16_t* abuf, const bf16_t* ebuf, LAS const unsigned char* raw, float* rkb, LAS float* stg, unsigned rbase, int ch, int h, int lane, const ScanC& C, float& pvr, float& pvk, float& pvv) {
    if constexpr (FROM_LDS) { asm volatile("s_waitcnt vmcnt(0)" ::: "memory"); __builtin_amdgcn_wave_barrier(); }
#pragma unroll 2
    for (int j = 0; j < 8; ++j) {
        const unsigned row = rbase + (unsigned)j;
        float cr, ck, cv, a, e;
        if constexpr (FROM_LDS) {
            LAS const bf16_t* rp = (LAS const bf16_t*)raw + j * 64 + lane;
            cr = bf2f(rp[0]); ck = bf2f(rp[512]); cv = bf2f(rp[1024]); a = bf2f(rp[1536]); e = bf2f(rp[2048]);
        } else {
            const unsigned pi = row * (unsigned)RPROJ + (unsigned)ch, ai = row * 512u + (unsigned)ch;
            cr = bf2f(pr[pi]); ck = bf2f(pr[pi + 512u]); cv = bf2f(pr[pi + 1024u]); a = bf2f(abuf[ai]); e = bf2f(ebuf[ai]);
        }
        const float xr = cr + (pvr - cr) * C.mu_r, xk = ck + (pvk - ck) * C.mu_k, xv = cv + (pvv - cv) * C.mu_v;
        pvr = cr; pvk = ck; pvv = cv;
        const float w = __builtin_amdgcn_exp2f(-e * L2E);
        const float kv = xk * C.kkc;
        const float ss = wave_sum(kv * kv);
        const float kkn = kv * __builtin_amdgcn_rsqf(fmaxf(ss, 1e-24f));
        const float kp = xk * (1.0f + (a - 1.0f) * C.kac);
        const float rk = wave_sum(xr * kp * C.rkc);
        if (lane == 0) rkb[row * 8u + (unsigned)h] = rk;
        LAS float* s = stg + j * STG_TOK + lane;
        s[0] = w; s[64] = kkn; s[128] = kkn * a; s[192] = kp; s[256] = xr; s[320] = xv;
    }
    asm volatile("s_waitcnt lgkmcnt(0)" ::: "memory");
    __builtin_amdgcn_wave_barrier();
}

DI void scan_task(const Params& p, int task, LAS float* stg, LAS unsigned char* raw, int lane) {
    const bf16_t* pr = (const bf16_t*)(p.ws + WS_PR);
    const bf16_t* abuf = (const bf16_t*)p.out;
    const bf16_t* ebuf = abuf + (size_t)M * 512;
    bf16_t* qt = (bf16_t*)(p.ws + WS_QB);
    bf16_t* ol = (bf16_t*)(p.ws + WS_KB);
    float* rkb = (float*)(p.ws + WS_RK);
    const int b = task >> 8, c = (task >> 3) & 31, h = task & 7, row0 = b * TP + c * 256;
    float* Uout = (float*)(p.ws + WS_UBUF) + (size_t)((b * 8 + h) * 32 + c) * 4096;
    float* Pout = (float*)(p.ws + WS_PBUF) + (size_t)((b * 8 + h) * 32 + c) * 4096;
    f32x2 P2[2][16], U2[2][16];
    int lane_v = lane; asm volatile("" : "+v"(lane_v));
    const int ch = h * 64 + lane_v, kh = lane_v >> 5, r = lane_v & 31;
#pragma unroll
    for (int rs = 0; rs < 2; ++rs) {
        const float d = (float)(kh * 32 - r - 32 * rs);
#pragma unroll
        for (int jp = 0; jp < 16; ++jp) { P2[rs][jp].x = fmaxf(1.0f - fabsf(d + (float)(2 * jp)), 0.f); P2[rs][jp].y = fmaxf(1.0f - fabsf(d + (float)(2 * jp + 1)), 0.f); U2[rs][jp].x = 0.f; U2[rs][jp].y = 0.f; }
    }
    ScanC C{p.in[12][ch], p.in[12][512 + ch], p.in[12][1024 + ch], p.in[18][ch], p.in[19][ch], p.in[20][ch]};
    float pvr = 0.f, pvk = 0.f, pvv = 0.f;
    if (c != 0) { const bf16_t* q = pr + (size_t)(row0 - 1) * RPROJ + ch; pvr = bf2f(q[0]); pvk = bf2f(q[512]); pvv = bf2f(q[1024]); }
    scan_prefetch8(pr, abuf, ebuf, raw, (unsigned)row0, h, lane);
#pragma unroll 1
    for (int t0 = 0; t0 < 256; t0 += 8) {
        const unsigned rbase = (unsigned)(row0 + t0);
        scan_stage8<true>(pr, abuf, ebuf, raw, rkb, stg, rbase, ch, h, lane, C, pvr, pvk, pvv);
        if (t0 + 8 < 256) scan_prefetch8(pr, abuf, ebuf, raw, rbase + 8u, h, lane);
#pragma unroll 1
        for (int j = 0; j < 8; ++j) {
            LAS const float* s = stg + j * STG_TOK + kh * 32;
#define SB __builtin_amdgcn_sched_barrier(0)
#define LD4(off) (*(LAS const f32x4*)(s + (off)))
            f32x4 kkv[8];
#pragma unroll
            for (int i = 0; i < 8; ++i) kkv[i] = LD4(64 + i * 4);
            const float vi0 = stg[j * STG_TOK + 320 + r], vi1 = stg[j * STG_TOK + 352 + r];
            f32x4 wb_[2], ab_[2], kb_[2], rb_[2];
            wb_[0] = LD4(0); ab_[0] = LD4(128); kb_[0] = LD4(192); rb_[0] = LD4(256);
            SB;
            f32x2 sp0 = {0.f, 0.f}, sp1 = sp0, su0 = sp0, su1 = sp0;
#pragma unroll
            for (int i = 0; i < 8; ++i) {
                const f32x2 ka = {kkv[i][0], kkv[i][1]}, kb = {kkv[i][2], kkv[i][3]};
                sp0 += P2[0][2 * i] * ka; sp0 += P2[0][2 * i + 1] * kb; sp1 += P2[1][2 * i] * ka; sp1 += P2[1][2 * i + 1] * kb;
                su0 += U2[0][2 * i] * ka; su0 += U2[0][2 * i + 1] * kb; su1 += U2[1][2 * i] * ka; su1 += U2[1][2 * i + 1] * kb;
            }
            float sP0 = sp0.x + sp0.y, sP1 = sp1.x + sp1.y, sU0 = su0.x + su0.y, sU1 = su1.x + su1.y;
            sP0 += __shfl_xor(sP0, 32); sP1 += __shfl_xor(sP1, 32); sU0 += __shfl_xor(sU0, 32); sU1 += __shfl_xor(sU1, 32);
            const f32x2 sPP0 = {sP0, sP0}, sPP1 = {sP1, sP1}, sUU0 = {sU0, sU0}, sUU1 = {sU1, sU1}, vv0 = {vi0, vi0}, vv1 = {vi1, vi1};
            f32x2 op0 = {0.f, 0.f}, op1 = op0, ou0 = op0, ou1 = op0;
#pragma unroll
            for (int bt = 0; bt < 8; ++bt) {
                const int cb = bt & 1, nb_ = cb ^ 1;
                if (bt < 7) { wb_[nb_] = LD4((bt + 1) * 4); ab_[nb_] = LD4(128 + (bt + 1) * 4); kb_[nb_] = LD4(192 + (bt + 1) * 4); rb_[nb_] = LD4(256 + (bt + 1) * 4); }
                SB;
                const f32x4 w4 = wb_[cb], a4 = ab_[cb], kp4 = kb_[cb], r4 = rb_[cb];
                const f32x2 wa = {w4[0], w4[1]}, wb = {w4[2], w4[3]}, aa = {a4[0], a4[1]}, ab = {a4[2], a4[3]};
                const f32x2 ka = {kp4[0], kp4[1]}, kb = {kp4[2], kp4[3]}, ra = {r4[0], r4[1]}, rb = {r4[2], r4[3]};
                P2[0][2 * bt] = P2[0][2 * bt] * wa - sPP0 * aa;          P2[0][2 * bt + 1] = P2[0][2 * bt + 1] * wb - sPP0 * ab;
                P2[1][2 * bt] = P2[1][2 * bt] * wa - sPP1 * aa;          P2[1][2 * bt + 1] = P2[1][2 * bt + 1] * wb - sPP1 * ab;
                U2[0][2 * bt] = U2[0][2 * bt] * wa - sUU0 * aa + vv0 * ka; U2[0][2 * bt + 1] = U2[0][2 * bt + 1] * wb - sUU0 * ab + vv0 * kb;
                U2[1][2 * bt] = U2[1][2 * bt] * wa - sUU1 * aa + vv1 * ka; U2[1][2 * bt + 1] = U2[1][2 * bt + 1] * wb - sUU1 * ab + vv1 * kb;
                op0 += P2[0][2 * bt] * ra; op0 += P2[0][2 * bt + 1] * rb; op1 += P2[1][2 * bt] * ra; op1 += P2[1][2 * bt + 1] * rb;
                ou0 += U2[0][2 * bt] * ra; ou0 += U2[0][2 * bt + 1] * rb; ou1 += U2[1][2 * bt] * ra; ou1 += U2[1][2 * bt + 1] * rb;
                SB;
            }
#undef SB
#undef LD4
            float oP0 = op0.x + op0.y, oP1 = op1.x + op1.y, oU0 = ou0.x + ou0.y, oU1 = ou1.x + ou1.y;
            oP0 += __shfl_xor(oP0, 32); oP1 += __shfl_xor(oP1, 32); oU0 += __shfl_xor(oU0, 32); oU1 += __shfl_xor(oU1, 32);
            const unsigned oi = (rbase + (unsigned)j) * 512u + (unsigned)ch;
            qt[oi] = f2bf(kh ? oP1 : oP0);
            ol[oi] = f2bf(kh ? oU1 : oU0);
        }
        __builtin_amdgcn_wave_barrier();
    }
#pragma unroll
    for (int rs = 0; rs < 2; ++rs)
#pragma unroll
        for (int jp = 0; jp < 16; ++jp) {
            *(f32x2*)(Pout + (r + 32 * rs) * 64 + kh * 32 + 2 * jp) = P2[rs][jp];
            *(f32x2*)(Uout + (r + 32 * rs) * 64 + kh * 32 + 2 * jp) = U2[rs][jp];
        }
}

constexpr int MS_KK = 0, MS_R = 2176, MS_NB = 4352, MS_KP = 6528, MS_NBT = 8704, MS_KPT = 10752, MS_VT = 12800, MS_AN = 14848, MS_BM = 15872, MS_C1 = 16384, MS_C2 = 16896,
              MS_LINV = 17408, MS_GEND = 17920, MS_BYTES = 18176, MS_PITCH = 136;
static_assert(8 * MS_BYTES <= LDS_BYTES - 64, "MFMA scan LDS");
DI bf16x8 ldfrag(LAS const unsigned char* p0, LAS const unsigned char* p1) { const u32x2 a = *(LAS const u32x2*)p0, b = *(LAS const u32x2*)p1; u32x4 w; w.x = a.x; w.y = a.y; w.z = b.x; w.w = b.y; return __builtin_bit_cast(bf16x8, w); }
DI bf16x8 zsel(bf16x8 f, bool valid) { u32x4 w = __builtin_bit_cast(u32x4, f); if (!valid) { w.x = 0u; w.y = 0u; w.z = 0u; w.w = 0u; } return __builtin_bit_cast(bf16x8, w); }
DI bf16x8 pack_lo8(const f32x16& x) { u32x4 w; w.x = pk2(x[0], x[1]); w.y = pk2(x[2], x[3]); w.z = pk2(x[4], x[5]); w.w = pk2(x[6], x[7]); return __builtin_bit_cast(bf16x8, w); }
DI bf16x8 pack_hi8(const f32x16& x) { u32x4 w; w.x = pk2(x[8], x[9]); w.y = pk2(x[10], x[11]); w.z = pk2(x[12], x[13]); w.w = pk2(x[14], x[15]); return __builtin_bit_cast(bf16x8, w); }
template <bool SAMPLE> DI void scan_task_mfma(const Params& p, int task, LAS unsigned char* ms, int lane) {
    const bf16_t* pr = (const bf16_t*)(p.ws + WS_PR);
    const bf16_t* abuf = (const bf16_t*)p.out;
    const bf16_t* ebuf = abuf + (size_t)M * 512;
    bf16_t* qt = (bf16_t*)(p.ws + WS_QB);
    bf16_t* ol = (bf16_t*)(p.ws + WS_KB);
    float* rkb = (float*)(p.ws + WS_RK);
    int b = 0, c = 0, h, row0, ntok; float* Uout; float* Pout = nullptr; const float* init = nullptr; const float* shp = nullptr;
    if constexpr (!SAMPLE) { b = task >> 8; c = (task >> 3) & 31; h = task & 7; row0 = b * TP + c * 256; ntok = 256;
        Uout = (float*)(p.ws + WS_UBUF) + (size_t)((b * 8 + h) * 32 + c) * 4096; Pout = (float*)(p.ws + WS_PBUF) + (size_t)((b * 8 + h) * 32 + c) * 4096; }
    else { const int sq = task >> 3; h = task & 7; row0 = MP + sq * 32; ntok = 32;
        init = p.in[4] + (size_t)(sq * 8 + h) * 4096; Uout = p.out + OUT_SWKV + (size_t)(sq * 8 + h) * 4096; shp = p.in[5] + (size_t)sq * RPROJ; }
    constexpr int CT0 = SAMPLE ? 2 : 0;
    int lane_v = lane; asm volatile("" : "+v"(lane_v));
    const int ch = h * 64 + lane_v;
#define MS_LANES int lv_ = lane; asm volatile("" : "+v"(lv_)); const int l32 = lv_ & 31, hi = lv_ >> 5, l16 = lv_ & 15; const bool rowok = l32 < 16; (void)l16; (void)rowok;
    f32x16 YT[2][4];
    { MS_LANES
#pragma unroll
    for (int kt = 0; kt < 2; ++kt)
#pragma unroll
        for (int ct = 0; ct < 4; ++ct)
#pragma unroll
            for (int r = 0; r < 16; ++r) YT[kt][ct][r] = (!SAMPLE && ct < 2 && (32 * kt + crow(r, hi)) == (ct * 32 + l32)) ? 1.f : 0.f;
    if constexpr (SAMPLE) {
#pragma unroll
        for (int ct = 2; ct < 4; ++ct)
#pragma unroll
            for (int kt = 0; kt < 2; ++kt)
#pragma unroll
                for (int g = 0; g < 4; ++g) {
                    const f32x4 iv = *(const f32x4*)(init + ((ct & 1) * 32 + l32) * 64 + 32 * kt + 8 * g + 4 * hi);
                    YT[kt][ct][4 * g] = iv[0]; YT[kt][ct][4 * g + 1] = iv[1]; YT[kt][ct][4 * g + 2] = iv[2]; YT[kt][ct][4 * g + 3] = iv[3];
                }
    }
    }
    ScanC C{p.in[12][ch], p.in[12][512 + ch], p.in[12][1024 + ch], p.in[18][ch], p.in[19][ch], p.in[20][ch]};
    float pvr = 0.f, pvk = 0.f, pvv = 0.f;
    if constexpr (SAMPLE) { pvr = shp[ch]; pvk = shp[512 + ch]; pvv = shp[1024 + ch]; }
    else if (c != 0) { const bf16_t* q = pr + (size_t)(row0 - 1) * RPROJ + ch; pvr = bf2f(q[0]); pvk = bf2f(q[512]); pvv = bf2f(q[1024]); }
#pragma unroll 1
    for (int t0 = 0; t0 < ntok; t0 += 16) {
        const unsigned rbase = (unsigned)(row0 + t0);
        {
            int lane = lane_v; asm volatile("" : "+v"(lane));
            float E = 0.f, G = 1.f;
            bf16_t rr_[16], rk_[16], rv_[16], ra_[16], re_[16];
#pragma unroll
            for (int j = 0; j < 16; ++j) {
                const unsigned row = rbase + (unsigned)j;
                const unsigned pi = row * (unsigned)RPROJ + (unsigned)ch, ai = row * 512u + (unsigned)ch;
                rr_[j] = pr[pi]; rk_[j] = pr[pi + 512u]; rv_[j] = pr[pi + 1024u]; ra_[j] = abuf[ai]; re_[j] = ebuf[ai];
            }
            __builtin_amdgcn_sched_barrier(0);
#pragma unroll
            for (int jp = 0; jp < 8; ++jp) {
                float nbv[2], kpv[2], vv[2];
#pragma unroll
                for (int u = 0; u < 2; ++u) {
                    const int j = 2 * jp + u;
                    const unsigned row = rbase + (unsigned)j;
                    const float cr = bf2f(rr_[j]), ck = bf2f(rk_[j]), cv = bf2f(rv_[j]);
                    const float a = bf2f(ra_[j]), e = bf2f(re_[j]);
                    const float xr = cr + (pvr - cr) * C.mu_r, xk = ck + (pvk - ck) * C.mu_k, xv = cv + (pvv - cv) * C.mu_v;
                    pvr = cr; pvk = ck; pvv = cv;
                    const float Gm1 = G;
                    E += e;
                    G = __builtin_amdgcn_exp2f(-E * L2E);
                    const float Gi = __builtin_amdgcn_exp2f(E * L2E);
                    const float kv = xk * C.kkc;
                    const float ss = wave_sum(kv * kv);
                    const float kkn = kv * __builtin_amdgcn_rsqf(fmaxf(ss, 1e-24f));
                    const float kp = xk * (1.0f + (a - 1.0f) * C.kac);
                    const float rk = wave_sum(xr * kp * C.rkc);
                    if (lane == 0) rkb[row * 8u + (unsigned)h] = rk;
                    const float kkt = Gm1 * kkn, rt = G * xr, nb = -(kkn * a) * Gi, kpg = kp * Gi;
                    LAS bf16_t* rowp = (LAS bf16_t*)(ms + j * MS_PITCH) + lane;
                    rowp[MS_KK / 2] = f2bf(kkt); rowp[MS_R / 2] = f2bf(rt); rowp[MS_NB / 2] = f2bf(nb); rowp[MS_KP / 2] = f2bf(kpg);
                    nbv[u] = nb; kpv[u] = kpg; vv[u] = xv;
                }
                ((LAS unsigned*)(ms + MS_NBT))[lane * 8 + jp] = pk2(nbv[0], nbv[1]);
                ((LAS unsigned*)(ms + MS_KPT))[lane * 8 + jp] = pk2(kpv[0], kpv[1]);
                ((LAS unsigned*)(ms + MS_VT))[lane * 8 + jp] = pk2(vv[0], vv[1]);
            }
            ((LAS float*)(ms + MS_GEND))[lane] = G;
        }
        asm volatile("s_waitcnt lgkmcnt(0)" ::: "memory");
        __builtin_amdgcn_wave_barrier();
        {
            MS_LANES
            f32x16 an, bm, c1, c2;
#pragma unroll
            for (int r = 0; r < 16; ++r) { an[r] = 0.f; bm[r] = 0.f; c1[r] = 0.f; c2[r] = 0.f; }
#pragma unroll
            for (int s4 = 0; s4 < 4; ++s4) {
                const int off = l16 * MS_PITCH + (16 * s4 + 8 * hi) * 2;
                const bf16x8 akk = zsel(ldfrag(ms + MS_KK + off, ms + MS_KK + off + 8), rowok), ar = zsel(ldfrag(ms + MS_R + off, ms + MS_R + off + 8), rowok);
                const bf16x8 bnb = ldfrag(ms + MS_NB + off, ms + MS_NB + off + 8), bkp = ldfrag(ms + MS_KP + off, ms + MS_KP + off + 8);
                an = MFMA32(akk, bnb, an); bm = MFMA32(akk, bkp, bm); c1 = MFMA32(ar, bnb, c1); c2 = MFMA32(ar, bkp, c2);
            }
            if (rowok) {
#pragma unroll
                for (int r = 0; r < 8; ++r) {
                    const int tau = crow(r, hi);
                    const bool lt = l32 < tau, le = l32 <= tau;
                    ((LAS float*)(ms + MS_AN))[tau * 16 + l32] = lt ? an[r] : 0.f;
                    ((LAS bf16_t*)(ms + MS_BM))[tau * 16 + l32] = f2bf(lt ? bm[r] : 0.f);
                    ((LAS bf16_t*)(ms + MS_C1))[tau * 16 + l32] = f2bf(le ? c1[r] : 0.f);
                    ((LAS bf16_t*)(ms + MS_C2))[tau * 16 + l32] = f2bf(le ? c2[r] : 0.f);
                }
            }
        }
        asm volatile("s_waitcnt lgkmcnt(0)" ::: "memory");
        __builtin_amdgcn_wave_barrier();
        {
            MS_LANES
            float x[16];
#pragma unroll
            for (int t = 0; t < 16; ++t) {
                float acc = (t == l16) ? 1.f : 0.f;
#pragma unroll
                for (int q4 = 0; q4 * 4 < t; ++q4) {
                    const f32x4 av = *(LAS const f32x4*)(ms + MS_AN + (t * 16 + q4 * 4) * 4);
#pragma unroll
                    for (int i = 0; i < 4; ++i) if (q4 * 4 + i < t) acc += av[i] * x[q4 * 4 + i];
                }
                x[t] = acc;
            }
            if (lv_ < 16) {
#pragma unroll
                for (int t = 0; t < 16; ++t) ((LAS bf16_t*)(ms + MS_LINV))[t * 16 + lv_] = f2bf(x[t]);
            }
        }
        asm volatile("s_waitcnt lgkmcnt(0)" ::: "memory");
        __builtin_amdgcn_wave_barrier();
#pragma unroll
        for (int ct = CT0; ct < 4; ++ct) {
            asm volatile("" ::: "memory");
            MS_LANES
            const int offp = l16 * 32 + 8 * hi;
            const bf16x8 linvA = zsel(ldfrag(ms + MS_LINV + offp, ms + MS_LINV + offp + 16), rowok);
            const bf16x8 c1A = zsel(ldfrag(ms + MS_C1 + offp, ms + MS_C1 + offp + 16), rowok);
            bf16x8 bmA, c2A;
            if (ct >= 2) { bmA = zsel(ldfrag(ms + MS_BM + l16 * 32 + 16 * hi, ms + MS_BM + l16 * 32 + 16 * hi + 8), rowok);
                           c2A = zsel(ldfrag(ms + MS_C2 + l16 * 32 + 16 * hi, ms + MS_C2 + l16 * 32 + 16 * hi + 8), rowok); }
            bf16x8 yb[2][2];
#pragma unroll
            for (int kt = 0; kt < 2; ++kt) { yb[kt][0] = pack_lo8(YT[kt][ct]); yb[kt][1] = pack_hi8(YT[kt][ct]); }
            bf16x8 vtb;
            if (ct >= 2) vtb = ldfrag(ms + MS_VT + ((ct & 1) * 32 + l32) * 32 + 16 * hi, ms + MS_VT + ((ct & 1) * 32 + l32) * 32 + 16 * hi + 8);
            f32x16 rhs, o;
#pragma unroll
            for (int r = 0; r < 16; ++r) { rhs[r] = 0.f; o[r] = 0.f; }
#pragma unroll
            for (int kt = 0; kt < 2; ++kt)
#pragma unroll
                for (int s2 = 0; s2 < 2; ++s2) {
                    const int off = l16 * MS_PITCH + (32 * kt + 16 * s2 + 4 * hi) * 2;
                    const bf16x8 akk = zsel(ldfrag(ms + MS_KK + off, ms + MS_KK + off + 16), rowok), ar = zsel(ldfrag(ms + MS_R + off, ms + MS_R + off + 16), rowok);
                    rhs = MFMA32(akk, yb[kt][s2], rhs);
                    o = MFMA32(ar, yb[kt][s2], o);
                }
            if (ct >= 2) rhs = MFMA32(bmA, vtb, rhs);
            const bf16x8 rb = pack_lo8(rhs);
            f32x16 sa;
#pragma unroll
            for (int r = 0; r < 16; ++r) sa[r] = 0.f;
            sa = MFMA32(linvA, rb, sa);
            const bf16x8 sab = pack_lo8(sa);
            o = MFMA32(c1A, sab, o);
            if (ct >= 2) o = MFMA32(c2A, vtb, o);
            {
                bf16_t* dst = (ct < 2 ? qt : ol);
                const unsigned oi = (rbase + 4u * (unsigned)hi) * 512u + (unsigned)(h * 64 + (ct & 1) * 32 + l32);
#pragma unroll
                for (int r = 0; r < 8; ++r) dst[oi + (unsigned)((r & 3) + 8 * (r >> 2)) * 512u] = f2bf(o[r]);
            }
#pragma unroll
            for (int kt = 0; kt < 2; ++kt) {
                const int offk = (32 * kt + l32) * 32;
                const bf16x8 nbA = ldfrag(ms + MS_NBT + offk + 8 * hi, ms + MS_NBT + offk + 8 * hi + 16);
                YT[kt][ct] = MFMA32(nbA, sab, YT[kt][ct]);
                if (ct >= 2) { const bf16x8 kpA = ldfrag(ms + MS_KPT + offk + 16 * hi, ms + MS_KPT + offk + 16 * hi + 8); YT[kt][ct] = MFMA32(kpA, vtb, YT[kt][ct]); }
#pragma unroll
                for (int g = 0; g < 4; ++g) {
                    const f32x4 gv = *(LAS const f32x4*)(ms + MS_GEND + (32 * kt + 8 * g + 4 * hi) * 4);
#pragma unroll
                    for (int i = 0; i < 4; ++i) YT[kt][ct][4 * g + i] *= gv[i];
                }
            }
        }
        asm volatile("s_waitcnt lgkmcnt(0)" ::: "memory");
        __builtin_amdgcn_wave_barrier();
    }
    MS_LANES
#pragma unroll
    for (int ct = CT0; ct < 4; ++ct) {
        if (ct < 2) {
#pragma unroll
            for (int kt = 0; kt < 2; ++kt)
#pragma unroll
                for (int r = 0; r < 16; ++r) Pout[(32 * kt + crow(r, hi)) * 64 + (ct & 1) * 32 + l32] = YT[kt][ct][r];
        } else {
            float* dst = Uout + ((ct & 1) * 32 + l32) * 64;
#pragma unroll
            for (int kt = 0; kt < 2; ++kt)
#pragma unroll
                for (int g = 0; g < 4; ++g)
                    *(f32x4*)(dst + 32 * kt + 8 * g + 4 * hi) = (f32x4){YT[kt][ct][4 * g], YT[kt][ct][4 * g + 1], YT[kt][ct][4 * g + 2], YT[kt][ct][4 * g + 3]};
        }
    }
}

DI void scan_sample_task(const Params& p, int task, LAS float* stg, int lane) {
    const bf16_t* pr = (const bf16_t*)(p.ws + WS_PR);
    const bf16_t* abuf = (const bf16_t*)p.out;
    const bf16_t* ebuf = abuf + (size_t)M * 512;
    bf16_t* ol = (bf16_t*)(p.ws + WS_KB);
    float* rkb = (float*)(p.ws + WS_RK);
    const int sq = task >> 3, h = task & 7, row0 = MP + sq * 32;
    const float* init = p.in[4] + (size_t)(sq * 8 + h) * 4096;
    float* Uout = p.out + OUT_SWKV + (size_t)(sq * 8 + h) * 4096;
    const float* shp = p.in[5] + (size_t)sq * RPROJ;
    const int ch = h * 64 + lane;
    float U[64];
#pragma unroll
    for (int k4 = 0; k4 < 16; ++k4) {
        const f32x4 iv = *(const f32x4*)(init + lane * 64 + k4 * 4);
        U[k4 * 4] = iv[0]; U[k4 * 4 + 1] = iv[1]; U[k4 * 4 + 2] = iv[2]; U[k4 * 4 + 3] = iv[3];
    }
    ScanC C{p.in[12][ch], p.in[12][512 + ch], p.in[12][1024 + ch], p.in[18][ch], p.in[19][ch], p.in[20][ch]};
    float pvr = shp[ch], pvk = shp[512 + ch], pvv = shp[1024 + ch];
#pragma unroll 1
    for (int t0 = 0; t0 < 32; t0 += 8) {
        const unsigned rbase = (unsigned)(row0 + t0);
        scan_stage8<false>(pr, abuf, ebuf, nullptr, rkb, stg, rbase, ch, h, lane, C, pvr, pvk, pvv);
#pragma unroll 1
        for (int j = 0; j < 8; ++j) {
            LAS const float* s = stg + j * STG_TOK;
            float sa0 = 0.f, sa1 = 0.f;
#pragma unroll
            for (int k4 = 0; k4 < 16; ++k4) {
                const f32x4 kk4 = *(LAS const f32x4*)(s + 64 + k4 * 4);
                sa0 += U[k4 * 4 + 0] * kk4[0]; sa1 += U[k4 * 4 + 1] * kk4[1]; sa0 += U[k4 * 4 + 2] * kk4[2]; sa1 += U[k4 * 4 + 3] * kk4[3];
            }
            const float sa = sa0 + sa1;
            const float vi = s[320 + lane];
            float o0 = 0.f, o1 = 0.f;
#pragma unroll
            for (int k4 = 0; k4 < 16; ++k4) {
                const f32x4 w4 = *(LAS const f32x4*)(s + k4 * 4), a4 = *(LAS const f32x4*)(s + 128 + k4 * 4), kp4 = *(LAS const f32x4*)(s + 192 + k4 * 4), r4 = *(LAS const f32x4*)(s + 256 + k4 * 4);
#pragma unroll
                for (int i = 0; i < 4; ++i) U[k4 * 4 + i] = U[k4 * 4 + i] * w4[i] - sa * a4[i] + vi * kp4[i];
                o0 += U[k4 * 4 + 0] * r4[0]; o1 += U[k4 * 4 + 1] * r4[1]; o0 += U[k4 * 4 + 2] * r4[2]; o1 += U[k4 * 4 + 3] * r4[3];
            }
            ol[(rbase + (unsigned)j) * 512u + (unsigned)ch] = f2bf(o0 + o1);
        }
        __builtin_amdgcn_wave_barrier();
    }
#pragma unroll
    for (int k = 0; k < 64; ++k) Uout[lane * 64 + k] = U[k];
}

#define MFMA16F(a, b, c) __builtin_amdgcn_mfma_f32_16x16x4f32((a), (b), (c), 0, 0, 0)
DI void chunk_scan_task(const Params& p, int task, int lane) {
    const int bh = task >> 2, rb = task & 3, n = lane & 15, q = lane >> 4, v = rb * 16 + n;
    const float* Pb = (const float*)(p.ws + WS_PBUF) + (size_t)bh * 32 * 4096;
    const float* Ub = (const float*)(p.ws + WS_UBUF) + (size_t)bh * 32 * 4096;
    float* Sst = (float*)(p.ws + WS_SST) + (size_t)bh * 33 * 4096;
    f32x4 ST[4];
#pragma unroll
    for (int kt = 0; kt < 4; ++kt) ST[kt] = (f32x4){0.f, 0.f, 0.f, 0.f};
    f32x4 pa[4][4], pb[4][4], ua[4], ub[4];
#define CS_LOAD(P_, U_, cc) do { const float* Pc = Pb + (size_t)(cc) * 4096; const float* Uc = Ub + (size_t)(cc) * 4096; \
        _Pragma("unroll") for (int kt = 0; kt < 4; ++kt) { U_[kt] = *(const f32x4*)(Uc + v * 64 + 16 * kt + 4 * q); \
            _Pragma("unroll") for (int ib = 0; ib < 4; ++ib) P_[kt][ib] = *(const f32x4*)(Pc + (16 * kt + n) * 64 + 16 * ib + 4 * q); } } while (0)
#define CS_STEP(P_, U_, Pn_, Un_, cc) do { const int c_ = (cc); \
        if (c_ + 1 < 32) CS_LOAD(Pn_, Un_, c_ + 1); \
        f32x4 nw[4]; \
        _Pragma("unroll") for (int kt = 0; kt < 4; ++kt) { *(f32x4*)(Sst + (size_t)c_ * 4096 + v * 64 + 16 * kt + 4 * q) = ST[kt]; nw[kt] = U_[kt]; } \
        _Pragma("unroll") for (int ib = 0; ib < 4; ++ib) _Pragma("unroll") for (int r = 0; r < 4; ++r) \
            _Pragma("unroll") for (int kt = 0; kt < 4; ++kt) nw[kt] = MFMA16F(P_[kt][ib][r], ST[ib][r], nw[kt]); \
        _Pragma("unroll") for (int kt = 0; kt < 4; ++kt) ST[kt] = nw[kt]; \
    } while (0)
    CS_LOAD(pa, ua, 0);
#pragma unroll 1
    for (int c = 0; c < 32; c += 2) { CS_STEP(pa, ua, pb, ub, c); CS_STEP(pb, ub, pa, ua, c + 1); }
#undef CS_STEP
#undef CS_LOAD
#pragma unroll
    for (int kt = 0; kt < 4; ++kt) *(f32x4*)(p.out + OUT_PWKV + (size_t)bh * 4096 + v * 64 + 16 * kt + 4 * q) = ST[kt];
}

DI void post_rows(const Params& p, int row0, int h, const f32x16 (&acc)[2], int lane);
DI void post_chunk(const Params& p, int task, int lane) {
    const int l32 = lane & 31, hi = lane >> 5;
    const bf16_t* qt = (const bf16_t*)(p.ws + WS_QB);
    const int b = task >> 8, c = (task >> 3) & 31, h = task & 7;
    const float* Sp = (const float*)(p.ws + WS_SST) + (size_t)((b * 8 + h) * 33 + c) * 4096;
    bf16x8 af[2][4];
    if (c > 0) {
#pragma unroll
        for (int vb = 0; vb < 2; ++vb)
#pragma unroll
            for (int ks = 0; ks < 4; ++ks) {
                const float* sp = Sp + (vb * 32 + l32) * 64 + ks * 16 + hi * 8;
                af[vb][ks] = __builtin_bit_cast(bf16x8, pack8(*(const f32x4*)sp, *(const f32x4*)(sp + 4)));
            }
    }
#pragma unroll 1
    for (int tb = 0; tb < 8; ++tb) {
        const int row0 = b * TP + c * 256 + tb * 32;
        f32x16 acc[2];
#pragma unroll
        for (int i = 0; i < 16; ++i) { acc[0][i] = 0.f; acc[1][i] = 0.f; }
        if (c > 0) {
#pragma unroll
            for (int ks = 0; ks < 4; ++ks) {
                const bf16x8 bq = *(const bf16x8*)(qt + (size_t)(row0 + l32) * 512 + h * 64 + ks * 16 + hi * 8);
                acc[0] = MFMA32(af[0][ks], bq, acc[0]);
                acc[1] = MFMA32(af[1][ks], bq, acc[1]);
            }
        }
        post_rows(p, row0, h, acc, lane);
    }
}
DI void post_sample(const Params& p, int su, int lane) {
    f32x16 acc[2];
#pragma unroll
    for (int i = 0; i < 16; ++i) { acc[0][i] = 0.f; acc[1][i] = 0.f; }
    post_rows(p, MP + (su >> 3) * 32, su & 7, acc, lane);
}
DI void post_rows(const Params& p, int row0, int h, const f32x16 (&acc)[2], int lane) {
    const int l32 = lane & 31, hi = lane >> 5;
    const bf16_t* pr = (const bf16_t*)(p.ws + WS_PR);
    const bf16_t* ol = (const bf16_t*)(p.ws + WS_KB);
    const bf16_t* gbuf = (const bf16_t*)p.out + (size_t)2 * M * 512;
    const float* rkb = (const float*)(p.ws + WS_RK);
    bf16_t* yr = (bf16_t*)(p.ws + WS_YR);
    const int row = row0 + l32;
    float o[2][16]; float sum = 0.f;
#pragma unroll
    for (int vb = 0; vb < 2; ++vb)
#pragma unroll
        for (int g = 0; g < 4; ++g) {
            const u32x2 w = *(const u32x2*)(ol + (size_t)row * 512 + h * 64 + vb * 32 + 8 * g + 4 * hi);
            o[vb][4 * g + 0] = acc[vb][4 * g + 0] + lo_bf(w.x); o[vb][4 * g + 1] = acc[vb][4 * g + 1] + hi_bf(w.x);
            o[vb][4 * g + 2] = acc[vb][4 * g + 2] + lo_bf(w.y); o[vb][4 * g + 3] = acc[vb][4 * g + 3] + hi_bf(w.y);
            sum += (o[vb][4 * g] + o[vb][4 * g + 1]) + (o[vb][4 * g + 2] + o[vb][4 * g + 3]);
        }
    sum += __shfl_xor(sum, 32);
    const float mean = sum * (1.0f / 64.0f);
    float var = 0.f;
#pragma unroll
    for (int vb = 0; vb < 2; ++vb)
#pragma unroll
        for (int i = 0; i < 16; ++i) { const float d = o[vb][i] - mean; var += d * d; }
    var += __shfl_xor(var, 32);
    const float rstd = __builtin_amdgcn_rsqf(var * (1.0f / 64.0f) + 64e-5f);
    const float rk = rkb[(size_t)row * 8 + h];
    int mode = 0; const float* sp = nullptr;
    if (row < MP) { if ((row & 8191) == 0) mode = 1; }
    else { const int sr = row - MP; if ((sr & 31) == 0) { mode = 2; sp = p.in[5] + (size_t)(sr >> 5) * RPROJ + 1024; } }
#pragma unroll
    for (int vb = 0; vb < 2; ++vb)
#pragma unroll
        for (int g = 0; g < 4; ++g) {
            const int chn = h * 64 + vb * 32 + 8 * g + 4 * hi;
            const u32x2 cv = *(const u32x2*)(pr + (size_t)row * RPROJ + 1024 + chn);
            f32x4 c4 = {lo_bf(cv.x), hi_bf(cv.x), lo_bf(cv.y), hi_bf(cv.y)}, p4;
            if (mode == 0) { const u32x2 pv = *(const u32x2*)(pr + (size_t)(row - 1) * RPROJ + 1024 + chn); p4 = (f32x4){lo_bf(pv.x), hi_bf(pv.x), lo_bf(pv.y), hi_bf(pv.y)}; }
            else if (mode == 1) p4 = (f32x4){0.f, 0.f, 0.f, 0.f};
            else p4 = *(const f32x4*)(sp + chn);
            const f32x4 mu = *(const f32x4*)(p.in[12] + 1024 + chn);
            const f32x4 xv = c4 + (p4 - c4) * mu;
            const f32x4 lg = *(const f32x4*)(p.in[21] + chn), lb = *(const f32x4*)(p.in[22] + chn);
            const u32x2 gw = *(const u32x2*)(gbuf + (size_t)row * 512 + chn);
            const f32x4 gg = {lo_bf(gw.x), hi_bf(gw.x), lo_bf(gw.y), hi_bf(gw.y)};
            f32x4 y;
#pragma unroll
            for (int i = 0; i < 4; ++i) y[i] = ((o[vb][4 * g + i] - mean) * rstd * lg[i] + lb[i] + rk * xv[i]) * gg[i];
            u32x2 w; w.x = pk2(y[0], y[1]); w.y = pk2(y[2], y[3]);
            *(u32x2*)(yr + (size_t)row * 1024 + chn) = w;
        }
}

#ifndef PH_MASK
#define PH_MASK 0xffffffffu
#endif
#define PH(k) ((PH_MASK >> (k)) & 1u)
#ifndef DUP_MASK
#define DUP_MASK 0u
#endif
#define REP(k) _Pragma("unroll 1") for (int rep_ = 0; rep_ < (((DUP_MASK >> (k)) & 1u) ? 2 : 1); ++rep_)
__global__ void __launch_bounds__(NTHREADS, 2) fwd_megakernel(Params p) {
    extern __shared__ __attribute__((aligned(16))) unsigned char lds_raw[];
    LAS unsigned char* lds = (LAS unsigned char*)lds_raw;
    cg::grid_group grid = cg::this_grid();
    const int wid = __builtin_amdgcn_readfirstlane((int)threadIdx.x >> 6);
    const int nb = gridDim.x, bid = blockIdx.x;
    const int vcu = (nb % 8 == 0) ? (bid % 8) * (nb / 8) + bid / 8 : bid;
    const int gw = vcu * NWAVES + wid, nw = nb * NWAVES;
    unsigned char* ws = p.ws;
    volatile LAS unsigned* bst = (volatile LAS unsigned*)(lds + LDS_BYTES - 64);
    { const int t_ = wid * 64 + lane_now(); if (t_ < 16) bst[t_] = 0u; }
    __syncthreads();
    XcdBarrier xbar = xcd_barrier_post((unsigned*)(ws + WS_BAR), bst); xbar.w0 = wid;
#define GRID_BAR() xcd_barrier(xbar)

    REP(0) if (PH(0)) phase0(p, lds, wid * 64 + lane_now(), bid, nb);
    if (nb == 0x7fffffff) grid.sync();
    GRID_BAR();
    REP(1) if (PH(1)) norm_phase<0>(p, nullptr, nullptr, 0, p.in[10], 0, 1024, (bf16_t*)(ws + WS_ACTA), gw, nw, lane_now());
    GRID_BAR();
    REP(2) if (PH(2)) {
        pg8::Gemm g{(const bf16_t*)(ws + WS_ACTA), (const bf16_t*)(ws + WS_WIN), M, INPROJ, D, D};
        pg8::StaticOrder S; S.init(M, INPROJ, nb, vcu);
        EpiProj E{(bf16_t*)(ws + WS_PR), (bf16_t*)(ws + WS_QB), (bf16_t*)(ws + WS_KB), (bf16_t*)(ws + WS_VT), (bf16_t*)(ws + WS_GATES), (bf16_t*)(ws + WS_KS), (bf16_t*)(ws + WS_VTS), p.out};
        pg8::gemm_phase<EpiProj, pg8::StaticOrder, true, true>(lds, g, S, E, wid);
    }
    GRID_BAR();
    REP(3) if (PH(3)) {
        const int lane = lane_now(), tid = wid * 64 + lane;
        LAS float* tab = (LAS float*)lds;
        for (int e = tid; e < 8 * 257; e += NTHREADS) tab[e] = (p.in[23][e] - p.in[23][(e / 257) * 257 + 256]) * L2E;
        __syncthreads();
        const bf16_t* qb = (const bf16_t*)(ws + WS_QB); const bf16_t* kb = (const bf16_t*)(ws + WS_KB); const bf16_t* vt = (const bf16_t*)(ws + WS_VT);
        bf16_t* ya = (bf16_t*)(ws + WS_YR) + 512;
        const int h = wid;
        const int per = (1024 + nb - 1) / nb;
#pragma unroll 1
        for (int i = 0; i < per; ++i) {
            const int un = vcu * per + i;
            if (un < 1024) {
                const int b = un >> 7, c = un & 127;
                const size_t row0 = (size_t)b * TP + (size_t)c * 64;
                const int jh0 = c >= 8 ? 0 : 2 * (8 - c);
                const size_t bh = (size_t)(b * 8 + h);
                attn_unit(qb + (bh * 8192 + (size_t)c * 64) * 64, kb + ((ptrdiff_t)(bh * 8192) + (ptrdiff_t)c * 64 - 512) * 64, vt + ((ptrdiff_t)(bh * 256) + 2 * c - 16) * 2048, jh0, 18, 64,
                          ya + row0 * 1024 + h * 64, tab + h * 257, lane);
            }
        }
#pragma unroll 1
        for (int s = nb - 1 - vcu; s < 16; s += nb) {
            const size_t row0 = (size_t)MP + (size_t)s * 32;
            const size_t sh = (size_t)(s * 8 + h);
            attn_unit(qb + (size_t)MP * 512 + sh * 32 * 64, (const bf16_t*)(ws + WS_KS) + sh * 576 * 64, (const bf16_t*)(ws + WS_VTS) + sh * 18 * 2048, 0, 17, 32,
                      ya + row0 * 1024 + h * 64, tab + h * 257, lane);
        }
#ifndef NO_PREP
        {
            const int lane = lane_now(), tid = wid * 64 + lane;
            {
                LAS float* lb = (LAS float*)(lds + TAB_BYTES + 36864);
                for (int e = tid; e < 1024; e += NTHREADS) lb[e] = e < 512 ? p.in[14][e] : p.in[16][e - 512];
            }
            PrepW W; prep_load(p, W, wid, lane);
            const int npb = nb > 32 ? nb - 16 : nb;
            if (vcu < npb) {
#pragma unroll 1
                for (int tile = vcu; tile < M / 64; tile += npb) prep_unit(p, W, tile, lds, tid, wid, lane);
            }
        }
#endif
    }
    GRID_BAR();
    REP(4) if (PH(4)) {
        const int lane = lane_now();
#pragma unroll 1
        for (int task = gw; task < 2048; task += nw) scan_task_mfma<false>(p, task, lds + wid * MS_BYTES, lane);
    }
    GRID_BAR();
    REP(5) if (PH(5)) {
        const int lane = lane_now();
        if (wid == 0) {
#pragma unroll 1
            for (int task = vcu; task < 256; task += nb) chunk_scan_task(p, task, lane);
        } else if (wid == 1) {
#pragma unroll 1
            for (int task = vcu; task < 128; task += nb) scan_task_mfma<true>(p, task, lds + wid * MS_BYTES, lane);
        }
    }
    GRID_BAR();
    REP(6) if (PH(6)) {
        const int lane = lane_now();
#pragma unroll 1
        for (int task = gw; task < 2048; task += nw) post_chunk(p, task, lane);
#pragma unroll 1
        for (int su = nw - 1 - gw; su < 128; su += nw) post_sample(p, su, lane);
    }
    GRID_BAR();
    REP(7) if (PH(7)) {
        pg8::StaticOrder S; S.init(M, D, nb, vcu);
        pg8::Gemm g{(const bf16_t*)(ws + WS_YR), (const bf16_t*)(ws + WS_WBRR), M, D, D, D};
        EpiMerge E{(const bf16_t*)(ws + WS_GATES), (bf16_t*)(ws + WS_ACTA)};
        pg8::gemm_phase<EpiMerge, pg8::StaticOrder, true, true>(lds, g, S, E, wid);
    }
    GRID_BAR();
    REP(9) if (PH(9)) {
        {
            pg8::Gemm g{(const bf16_t*)(ws + WS_ACTA), (const bf16_t*)(ws + WS_WOUT), MP, D, D, D};
            pg8::StaticOrder S; S.init(MP, D, nb, vcu);
            EpiResB16 E{p.in[0], (const float*)(ws + WS_MOD), 2048, (bf16_t*)(ws + WS_YR), false};
            pg8::gemm_phase<EpiResB16, pg8::StaticOrder, true, true>(lds, g, S, E, wid);
        }
        {
            pg8::Gemm g{(const bf16_t*)(ws + WS_ACTA), (const bf16_t*)(ws + WS_WOUT), M, D, 256, D};
            SliceOrder S{nb, vcu, 4, 256, 4};
            EpiResPart E{(const float*)(ws + WS_MOD), 2048, (float*)(ws + WS_PART1), 256};
            pg8::gemm_phase<EpiResPart, SliceOrder, false, true>(lds, g, S, E, wid);
        }
    }
    GRID_BAR();
    REP(10) if (PH(10)) norm_phase<1>(p, (bf16_t*)(ws + WS_YR), (const float*)(ws + WS_PART1), 4, p.in[27], 3072, 4096, (bf16_t*)(ws + WS_ACTA), gw, nw, lane_now());
    GRID_BAR();
    REP(11) if (PH(11)) {
        pg8::Gemm g{(const bf16_t*)(ws + WS_ACTA), (const bf16_t*)(ws + WS_W1), M, DFF, D, D};
        pg8::StaticOrder S; S.init(M, DFF, nb, vcu);
        EpiSqrelu E{(bf16_t*)(ws + WS_PR)};
        pg8::gemm_phase<EpiSqrelu, pg8::StaticOrder, true, true>(lds, g, S, E, wid);
    }
    GRID_BAR();
    if (PH(12)) {
        {
            pg8::Gemm g{(const bf16_t*)(ws + WS_PR), (const bf16_t*)(ws + WS_W2), MP, D, DFF, DFF};
            RevRowOrder S; S.init(MP, D, nb, vcu);
            EpiResB16 E{nullptr, (const float*)(ws + WS_MOD), 5120, (bf16_t*)(ws + WS_YR), true};
            pg8::gemm_phase<EpiResB16, RevRowOrder, true, true>(lds, g, S, E, wid);
        }
        {
            pg8::Gemm g{(const bf16_t*)(ws + WS_PR), (const bf16_t*)(ws + WS_W2), M, D, 512, DFF};
            SliceOrder S{nb, vcu, 8, 512, 4};
            EpiResPart E{(const float*)(ws + WS_MOD), 5120, (float*)(ws + WS_PART2), 512};
            pg8::gemm_phase<EpiResPart, SliceOrder, false, true>(lds, g, S, E, wid);
        }
    }
    GRID_BAR();
    if (PH(13)) norm_phase<2>(p, (bf16_t*)(ws + WS_YR), (const float*)(ws + WS_PART2), 8, p.in[30], 0, 0, nullptr, gw, nw, lane_now());
}

extern "C" void kernel_launch(void* const* d_in, const int* in_sizes, int n_in, void* d_out, int out_size, void* d_ws, size_t ws_size, hipStream_t stream) {
    static int grid = 0;
    if (grid == 0) {
        if (n_in != 31 || ws_size < WS_END || out_size != 73181184) { fprintf(stderr, "kernel_launch: unexpected shapes (n_in %d, ws %zu, out %d)\n", n_in, ws_size, out_size); grid = -1; return; }
        int dev = 0, cus = 0, per_cu = 0;
        hipGetDevice(&dev);
        hipDeviceGetAttribute(&cus, hipDeviceAttributeMultiprocessorCount, dev);
        if (hipFuncSetAttribute((const void*)fwd_megakernel, hipFuncAttributeMaxDynamicSharedMemorySize, LDS_BYTES) != hipSuccess) { fprintf(stderr, "hipFuncSetAttribute failed\n"); grid = -1; return; }
        if (hipOccupancyMaxActiveBlocksPerMultiprocessor(&per_cu, (const void*)fwd_megakernel, NTHREADS, LDS_BYTES) != hipSuccess || per_cu < 1) { fprintf(stderr, "occupancy query failed (%d)\n", per_cu); per_cu = 1; }
        (void)hipGetLastError();
        grid = cus * per_cu;
    }
    if (grid < 0) return;
    if (hipMemsetAsync((char*)d_ws + WS_BAR, 0, WS_BAR_BYTES, stream) != hipSuccess) { fprintf(stderr, "kernel_launch: memset of the barrier words failed\n"); return; }
    Params p{};
    for (int i = 0; i < 31; ++i) p.in[i] = (const float*)d_in[i];
    p.out = (float*)d_out; p.ws = (unsigned char*)d_ws;
    void* args[] = {&p};
    hipError_t e = hipLaunchCooperativeKernel((const void*)fwd_megakernel, dim3(grid), dim3(NTHREADS), args, LDS_BYTES, stream);
    if (e != hipSuccess) fprintf(stderr, "cooperative launch failed: %s (grid %d)\n", hipGetErrorString(e), grid);
}
```
